# Optimizing an MI355X kernel written in HIP

```python
import jax, jax.numpy as jnp
from jax import lax
import numpy as np

D_MODEL = 1024
BATCH = 8
SEQ = 2048
DEPTH = 1
DEC_BATCH = 128
DEC_SEQ = 1
PAST_LEN = 2048
PAGE_SIZE = 128

H_ATT = 8
DH_ATT = 64
ATT_WIDTH = H_ATT * DH_ATT
MOBA_BLOCK = 256
MOBA_TOPK = 3
Q_CHUNK = 32
H_MLSTM = 4
DK_MLSTM = 128
DV_MLSTM = 128
MLSTM_WIDTH = H_MLSTM * DV_MLSTM
MLSTM_CHUNK = 64
MIX_WIDTH = ATT_WIDTH + MLSTM_WIDTH
D_FF = ((8 * D_MODEL + 3 * 256 - 1) // (3 * 256)) * 256
ALPHA = (2.0 * DEPTH) ** 0.25
BETA = (8.0 * DEPTH) ** -0.25
LN_EPS = 1e-5
NEG = -1e30
IN_SIZES = (ATT_WIDTH, ATT_WIDTH, ATT_WIDTH, H_MLSTM * DK_MLSTM, H_MLSTM * DK_MLSTM,
            MLSTM_WIDTH, MLSTM_WIDTH, H_MLSTM, H_MLSTM)
IN_SPLITS = tuple(int(s) for s in np.cumsum(IN_SIZES)[:-1])
IN_COLS = sum(IN_SIZES)

kernel_name = 'hymba_moba_mlstm_deepnorm_adaln_step'


def _layernorm(x, g, b):
    xf = x.astype(jnp.float32)
    mu = xf.mean(-1, keepdims=True)
    var = jnp.square(xf - mu).mean(-1, keepdims=True)
    return ((xf - mu) * lax.rsqrt(var + LN_EPS) * g + b).astype(x.dtype)


def _adaln(c, w_ada, b_ada):
    return jnp.split(jax.nn.silu(c) @ w_ada + b_ada, 6, axis=-1)


def _in_proj(x, shift, scale, w_in, b_if):
    B, S, _ = x.shape
    h = x * (1.0 + scale[:, None, :]) + shift[:, None, :]
    aq, ak, av, mq, mk, mv, mo, mi, mf = jnp.split(h @ w_in, IN_SPLITS, axis=-1)
    att = lambda t: t.reshape(B, S, H_ATT, DH_ATT)
    mq = mq.reshape(B, S, H_MLSTM, DK_MLSTM).astype(jnp.float32)
    mk = (mk.reshape(B, S, H_MLSTM, DK_MLSTM) * DK_MLSTM ** -0.5).astype(jnp.float32)
    mv = mv.reshape(B, S, H_MLSTM, DV_MLSTM).astype(jnp.float32)
    ig = (mi + b_if[:H_MLSTM]).astype(jnp.float32)
    lf = jax.nn.log_sigmoid((mf + b_if[H_MLSTM:]).astype(jnp.float32))
    return att(aq), att(ak), att(av), mq, mk, mv, mo, ig, lf


def _moba_core(q, qblk, kmean, kb, vb, s_own, own_mask):
    B, Q, H, Dh = q.shape
    nb = kb.shape[1]
    scale = DH_ATT ** -0.5
    blk_score = jnp.einsum('bqhd,bnhd->bqhn', q.astype(jnp.float32), kmean)
    past = jnp.arange(nb)[None, :] < qblk[:, None]
    blk_score = jnp.where(past[None, :, None, :], blk_score, NEG)
    _, sel = lax.top_k(blk_score, min(MOBA_TOPK, nb))
    valid = sel < qblk[None, :, None, None]
    bi = jnp.arange(B)[:, None, None, None]
    hi = jnp.arange(H)[None, None, :, None]
    k_sel = kb[bi, sel, :, hi]
    v_sel = vb[bi, sel, :, hi]
    n_sel = sel.shape[-1] * MOBA_BLOCK
    s_sel = jnp.einsum('bqhd,bqhjsd->bqhjs', q, k_sel,
                       preferred_element_type=jnp.float32).reshape(B, Q, H, n_sel)
    mask_sel = jnp.broadcast_to(valid[..., None], k_sel.shape[:-1]).reshape(B, Q, H, n_sel)
    s = jnp.concatenate([jnp.where(own_mask, s_own * scale, NEG),
                         jnp.where(mask_sel, s_sel * scale, NEG)], axis=-1)
    p = jax.nn.softmax(s, axis=-1).astype(vb.dtype)
    p_own = p[..., :MOBA_BLOCK]
    p_sel = p[..., MOBA_BLOCK:].reshape(k_sel.shape[:-1])
    o_sel = jnp.einsum('bqhjs,bqhjsd->bqhd', p_sel, v_sel)
    return p_own, o_sel


def _moba_prompt(q, k, v):
    B, S, H, Dh = q.shape
    nb = -(-S // MOBA_BLOCK)
    pad = ((0, 0), (0, nb * MOBA_BLOCK - S), (0, 0), (0, 0))
    kb = jnp.pad(k, pad).reshape(B, nb, MOBA_BLOCK, H, Dh)
    vb = jnp.pad(v, pad).reshape(B, nb, MOBA_BLOCK, H, Dh)
    kmean = kb.astype(jnp.float32).mean(axis=2)

    def q_block(ci):
        start = ci * Q_CHUNK
        qc = lax.dynamic_slice_in_dim(q, start, Q_CHUNK, axis=1)
        pos = start + jnp.arange(Q_CHUNK)
        blk = start // MOBA_BLOCK
        k_own = lax.dynamic_index_in_dim(kb, blk, axis=1, keepdims=False)
        v_own = lax.dynamic_index_in_dim(vb, blk, axis=1, keepdims=False)
        s_own = jnp.einsum('bqhd,bshd->bqhs', qc, k_own, preferred_element_type=jnp.float32)
        own_mask = (blk * MOBA_BLOCK + jnp.arange(MOBA_BLOCK))[None, :] <= pos[:, None]
        p_own, o_sel = _moba_core(qc, pos // MOBA_BLOCK, kmean, kb, vb, s_own,
                                  own_mask[None, :, None, :])
        return (o_sel + jnp.einsum('bqhs,bshd->bqhd', p_own, v_own)).astype(q.dtype)

    out = lax.map(q_block, jnp.arange(S // Q_CHUNK))
    return jnp.moveaxis(out, 0, 1).reshape(B, S, H * Dh)


def _moba_sample(q, k, v, cache_k, cache_v, page_table):
    B, T, H, Dh = q.shape
    past_len = page_table.shape[1] * PAGE_SIZE
    total = past_len + T
    nb = -(-total // MOBA_BLOCK)
    fill = jnp.zeros((B, nb * MOBA_BLOCK - total, H, Dh), k.dtype)
    kb = jnp.concatenate([cache_k[page_table].reshape(B, past_len, H, Dh).astype(k.dtype), k, fill],
                         axis=1).reshape(B, nb, MOBA_BLOCK, H, Dh)
    vb = jnp.concatenate([cache_v[page_table].reshape(B, past_len, H, Dh).astype(v.dtype), v, fill],
                         axis=1).reshape(B, nb, MOBA_BLOCK, H, Dh)
    kmean = kb.astype(jnp.float32).mean(axis=2)
    pos = past_len + jnp.arange(T)
    qblk = pos // MOBA_BLOCK
    k_own = kb[:, qblk]
    v_own = vb[:, qblk]
    s_own = jnp.einsum('bqhd,bqshd->bqhs', q, k_own, preferred_element_type=jnp.float32)
    own_mask = (qblk[:, None] * MOBA_BLOCK + jnp.arange(MOBA_BLOCK)[None, :]) <= pos[:, None]
    p_own, o_sel = _moba_core(q, qblk, kmean, kb, vb, s_own, own_mask[None, :, None, :])
    out = o_sel + jnp.einsum('bqhs,bqshd->bqhd', p_own, v_own)
    return out.astype(q.dtype).reshape(B, T, H * Dh)


def _mlstm_chunk(carry, inp):
    C, n, m = carry
    q, k, v, ig, lf = inp
    L = q.shape[1]
    b = jnp.cumsum(lf, axis=1)
    causal = jnp.tril(jnp.ones((L, L), bool))
    dmat = jnp.where(causal[None, :, :, None],
                     b[:, :, None, :] - b[:, None, :, :] + ig[:, None, :, :], NEG)
    m_inter = b + m[:, None, :]
    m_t = jnp.maximum(m_inter, dmat.max(axis=2))
    w_inter = jnp.exp(m_inter - m_t)
    a = jnp.exp(dmat - m_t[:, :, None, :]) * jnp.einsum('bthd,bjhd->btjh', q, k)
    num = w_inter[..., None] * jnp.einsum('bhvd,bthd->bthv', C, q) + jnp.einsum('btjh,bjhv->bthv', a, v)
    den = w_inter * jnp.einsum('bhd,bthd->bth', n, q) + a.sum(axis=2)
    h = num / jnp.maximum(jnp.abs(den), jnp.exp(-m_t))[..., None]
    m_new = m_t[:, -1]
    g_inter = jnp.exp(b[:, -1] + m - m_new)
    g_in = jnp.exp(b[:, -1:] - b + ig - m_new[:, None])
    C_new = g_inter[..., None, None] * C + jnp.einsum('bjh,bjhv,bjhd->bhvd', g_in, v, k)
    n_new = g_inter[..., None] * n + jnp.einsum('bjh,bjhd->bhd', g_in, k)
    return (C_new, n_new, m_new), h


def _mlstm_prompt(q, k, v, ig, lf):
    B, S = q.shape[:2]
    nc = S // MLSTM_CHUNK
    chunks = lambda a: jnp.moveaxis(a.reshape(B, nc, MLSTM_CHUNK, *a.shape[2:]), 1, 0)
    init = (jnp.zeros((B, H_MLSTM, DV_MLSTM, DK_MLSTM), jnp.float32),
            jnp.zeros((B, H_MLSTM, DK_MLSTM), jnp.float32),
            jnp.zeros((B, H_MLSTM), jnp.float32))
    state, h = lax.scan(_mlstm_chunk, init, (chunks(q), chunks(k), chunks(v), chunks(ig), chunks(lf)))
    return jnp.moveaxis(h, 0, 1).reshape(B, S, H_MLSTM, DV_MLSTM), state


def _mlstm_out(h, o, g):
    mu = h.mean(-1, keepdims=True)
    var = jnp.square(h - mu).mean(-1, keepdims=True)
    hn = ((h - mu) * lax.rsqrt(var + LN_EPS)).reshape(*h.shape[:2], MLSTM_WIDTH)
    return (hn * g * jax.nn.sigmoid(o.astype(jnp.float32))).astype(o.dtype)


def _finish(x, att, mem, g1, sh2, sc2, g2, w_out, ln1_g, ln1_b, w_gate, w_up, w_down, ln2_g, ln2_b):
    mix = jnp.concatenate([att, mem], axis=-1) @ w_out
    x = _layernorm(ALPHA * x + (1.0 + g1[:, None, :]) * mix, ln1_g, ln1_b)
    h = x * (1.0 + sc2[:, None, :]) + sh2[:, None, :]
    f = (jax.nn.silu(h @ w_gate) * (h @ w_up)) @ w_down
    return _layernorm(ALPHA * x + (1.0 + g2[:, None, :]) * f, ln2_g, ln2_b)


def _layer_prompt(x, c, weights):
    (w_ada, b_ada, w_in, b_if, mlstm_norm_g, w_out, ln1_g, ln1_b,
     w_gate, w_up, w_down, ln2_g, ln2_b) = weights
    sh1, sc1, g1, sh2, sc2, g2 = _adaln(c, w_ada, b_ada)
    aq, ak, av, mq, mk, mv, mo, ig, lf = _in_proj(x, sh1, sc1, w_in, b_if)
    att = _moba_prompt(aq, ak, av)
    h, (C, n, m) = _mlstm_prompt(mq, mk, mv, ig, lf)
    y = _finish(x, att, _mlstm_out(h, mo, mlstm_norm_g), g1, sh2, sc2, g2,
                w_out, ln1_g, ln1_b, w_gate, w_up, w_down, ln2_g, ln2_b)
    return y, ak, av, C.astype(x.dtype), n.astype(x.dtype), m.astype(x.dtype)


def _layer_sample(x, c, cache_k, cache_v, page_table, C0, n0, m0, weights):
    (w_ada, b_ada, w_in, b_if, mlstm_norm_g, w_out, ln1_g, ln1_b,
     w_gate, w_up, w_down, ln2_g, ln2_b) = weights
    sh1, sc1, g1, sh2, sc2, g2 = _adaln(c, w_ada, b_ada)
    aq, ak, av, mq, mk, mv, mo, ig, lf = _in_proj(x, sh1, sc1, w_in, b_if)
    att = _moba_sample(aq, ak, av, cache_k, cache_v, page_table)
    carry = (C0.astype(jnp.float32), n0.astype(jnp.float32), m0.astype(jnp.float32))
    (C, n, m), h = _mlstm_chunk(carry, (mq, mk, mv, ig, lf))
    y = _finish(x, att, _mlstm_out(h, mo, mlstm_norm_g), g1, sh2, sc2, g2,
                w_out, ln1_g, ln1_b, w_gate, w_up, w_down, ln2_g, ln2_b)
    return y, ak, av, C.astype(x.dtype), n.astype(x.dtype), m.astype(x.dtype)


def setup_inputs(seed: int = 0) -> dict:
    key = jax.random.key(seed)
    ks = jax.random.split(key, 26)
    n_pages = PAST_LEN // PAGE_SIZE
    n_used = DEC_BATCH * n_pages
    n_phys = n_used + max(1, n_used // 4)
    nrm = lambda k, shape, s: jax.random.normal(k, shape, jnp.float32) * s
    page_table = jax.random.permutation(ks[7], n_phys)[:n_used].reshape(DEC_BATCH, n_pages).astype(jnp.int32)
    f_bias = jnp.broadcast_to(jnp.linspace(3.0, 6.0, H_MLSTM), (DEPTH, H_MLSTM))
    b_if = jnp.concatenate([jnp.full((DEPTH, H_MLSTM), -2.0), f_bias], axis=-1) + nrm(ks[13], (DEPTH, 2 * H_MLSTM), 0.1)
    return {
        'x_prompt': nrm(ks[0], (BATCH, SEQ, D_MODEL), 1.0),
        'x_sample': nrm(ks[1], (DEC_BATCH, DEC_SEQ, D_MODEL), 1.0),
        'cache_k': nrm(ks[2], (DEPTH, n_phys, PAGE_SIZE, H_ATT, DH_ATT), 1.0),
        'cache_v': nrm(ks[3], (DEPTH, n_phys, PAGE_SIZE, H_ATT, DH_ATT), 1.0),
        'state_C': nrm(ks[4], (DEPTH, DEC_BATCH, H_MLSTM, DV_MLSTM, DK_MLSTM), 0.5),
        'state_n': nrm(ks[5], (DEPTH, DEC_BATCH, H_MLSTM, DK_MLSTM), 0.5),
        'state_m': nrm(ks[6], (DEPTH, DEC_BATCH, H_MLSTM), 1.0),
        'page_table': page_table,
        'c_prompt': nrm(ks[8], (BATCH, D_MODEL), 1.0),
        'c_sample': nrm(ks[9], (DEC_BATCH, D_MODEL), 1.0),
        'w_ada': nrm(ks[10], (DEPTH, D_MODEL, 6 * D_MODEL), 0.1 * D_MODEL ** -0.5),
        'b_ada': nrm(ks[11], (DEPTH, 6 * D_MODEL), 0.01),
        'w_in': nrm(ks[12], (DEPTH, D_MODEL, IN_COLS), D_MODEL ** -0.5),
        'b_if': b_if,
        'mlstm_norm_g': 1.0 + nrm(ks[14], (DEPTH, MLSTM_WIDTH), 0.01),
        'w_out': nrm(ks[15], (DEPTH, MIX_WIDTH, D_MODEL), BETA * MIX_WIDTH ** -0.5),
        'ln1_g': 1.0 + nrm(ks[16], (DEPTH, D_MODEL), 0.01),
        'ln1_b': nrm(ks[17], (DEPTH, D_MODEL), 0.01),
        'w_gate': nrm(ks[18], (DEPTH, D_MODEL, D_FF), D_MODEL ** -0.5),
        'w_up': nrm(ks[19], (DEPTH, D_MODEL, D_FF), D_MODEL ** -0.5),
        'w_down': nrm(ks[20], (DEPTH, D_FF, D_MODEL), BETA * D_FF ** -0.5),
        'ln2_g': 1.0 + nrm(ks[21], (DEPTH, D_MODEL), 0.01),
        'ln2_b': nrm(ks[22], (DEPTH, D_MODEL), 0.01),
    }


def reference(x_prompt, x_sample, cache_k, cache_v, state_C, state_n, state_m, page_table,
              c_prompt, c_sample, w_ada, b_ada, w_in, b_if, mlstm_norm_g, w_out,
              ln1_g, ln1_b, w_gate, w_up, w_down, ln2_g, ln2_b):
    y_prompt, y_sample = x_prompt, x_sample
    new_p, new_s = [], []
    for l in range(DEPTH):
        wl = (w_ada[l], b_ada[l], w_in[l], b_if[l], mlstm_norm_g[l], w_out[l], ln1_g[l], ln1_b[l],
              w_gate[l], w_up[l], w_down[l], ln2_g[l], ln2_b[l])
        y_prompt, *sp = _layer_prompt(y_prompt, c_prompt, wl)
        y_sample, *ss = _layer_sample(y_sample, c_sample, cache_k[l], cache_v[l], page_table,
                                      state_C[l], state_n[l], state_m[l], wl)
        new_p.append(sp)
        new_s.append(ss)
    k_prompt, v_prompt, C_prompt, n_prompt, m_prompt = (jnp.stack(a) for a in zip(*new_p))
    k_sample, v_sample, C_sample, n_sample, m_sample = (jnp.stack(a) for a in zip(*new_s))
    return (y_prompt, y_sample, k_prompt, v_prompt, C_prompt, n_prompt, m_prompt,
            k_sample, v_sample, C_sample, n_sample, m_sample)
```

```cpp
#include <hip/hip_runtime.h>
#include <cstdio>
#include <cstdint>
namespace pg8 {
#define PG8_LAS __attribute__((address_space(3)))
typedef unsigned short bf16_t;
typedef short bf16x8 __attribute__((ext_vector_type(8)));
typedef float f32x4 __attribute__((ext_vector_type(4)));
typedef unsigned u32x4 __attribute__((ext_vector_type(4)));
constexpr int BM = 256, BK = 64, HALF = 128, HTB = HALF * BK * 2  , STAGE_BYTES = 8 * HTB, NXCD = 8, WGM = 8;

__host__ __device__ __forceinline__ int lds_byte(int r, int c) { const int st = (r >> 4) * 2 + (c >> 5), rr = r & 15, cc = c & 31, ob = rr * 64 + cc * 2; return st * 1024 + (ob ^ (((ob >> 9) & 1) << 5)); }
__host__ __device__ __forceinline__ void stage_rc(int b, int& R, int& C) { const int st = b / 1024, sb = b % 1024, swz = sb ^ (((sb >> 9) & 1) << 5); R = (st >> 1) * 16 + swz / 64; C = (st & 1) * 32 + (swz % 64) / 2; }
__host__ __device__ __forceinline__ int perm32(int rho) { const int n = rho >> 4, i = rho & 15; return 8 * (i >> 2) + 4 * n + (i & 3); }

struct Unit { int pm, pn; };
struct Gemm { const bf16_t* A; const bf16_t* Bt; int M, N, K; };

struct StaticOrder {
    int nM, nN, nwg, G, c;
    __host__ __device__ void init(int M, int N, int G_, int c_) { nM = M / BM; nN = N / BM; nwg = nM * nN; G = G_; c = c_; }
    __host__ __device__ bool next(int i, Unit& u) const {
        const long L = (long)i * G + c; if (L >= nwg) return false;
        int wgid = (int)L; { const int q = nwg / NXCD, r = nwg % NXCD, xcd = wgid % NXCD, off = wgid / NXCD; wgid = (xcd < r ? xcd * (q + 1) : r * (q + 1) + (xcd - r) * q) + off; }
        const int nig = WGM * nN, gid = wgid / nig, fm = gid * WGM, gsz = (nM - fm) < WGM ? (nM - fm) : WGM;
        u.pm = fm + ((wgid % nig) % gsz); u.pn = (wgid % nig) / gsz; return true;
    }
    __device__ __forceinline__ void a_ready(const Unit&) const {}
    __device__ __forceinline__ void done(const Unit&) const {}
};

__device__ __forceinline__ unsigned cvt_pk_bf16(float lo, float hi) { unsigned r; asm volatile("v_cvt_pk_bf16_f32 %0, %1, %2" : "=v"(r) : "v"(lo), "v"(hi)); return r; }
typedef float f32x2 __attribute__((ext_vector_type(2)));
__device__ __forceinline__ f32x2 gelu_pk(f32x2 v) {
    const f32x2 av = __builtin_elementwise_abs(v), d = av * 0.2316418882f + 1.0f;
    f32x2 t; t.x = __builtin_amdgcn_rcpf(d.x); t.y = __builtin_amdgcn_rcpf(d.y);
    f32x2 q = t * 0.5307027145f + (-0.7265760135f); q = q * t + 0.7107068705f; q = q * t + (-0.142248368f); q = q * t + 0.127414796f; q = q * t;
    const f32x2 s = (v * v) * (-0.72134752044f);
    f32x2 e; e.x = __builtin_amdgcn_exp2f(s.x); e.y = __builtin_amdgcn_exp2f(s.y);
    const f32x2 m = v * (q * e), r = v - m;
    f32x2 o; o.x = v.x < 0.f ? m.x : r.x; o.y = v.y < 0.f ? m.y : r.y; return o;
}

template <int ACT  > struct EpiBf16 {
    static constexpr bool PERM = true, AFTER_DRAIN = false; static_assert(ACT == 0 || ACT == 1, "EpiBf16: ACT is 0 (none) or 1 (gelu_pk)");
    bf16_t* O; int ldc; const float* bias; int split_cols; size_t split_stride; float scale0;
    __device__ __forceinline__ void operator()(const f32x4 (&acc)[2][2][4][2], const Unit& u, int wr, int wc, int fr, int fq) const {
        const int row0 = u.pm * BM + wr * 64 + fr; int colt = u.pn * BM; bf16_t* base = O;
        float sc = 1.f; if (split_cols) { const int t = colt / split_cols; base += (size_t)t * split_stride; colt -= t * split_cols; if (t == 0) sc = scale0; }
        const int col0 = colt + wc * 32 + 8 * fq, bcol0 = u.pn * BM + wc * 32 + 8 * fq;
        f32x4 bv[2][2];
#pragma unroll
        for (int bj = 0; bj < 2; ++bj)
#pragma unroll
            for (int n = 0; n < 2; ++n) bv[bj][n] = bias ? *(const f32x4*)(bias + bcol0 + bj * HALF + 4 * n) : (f32x4){0.f, 0.f, 0.f, 0.f};
#pragma unroll
        for (int ai = 0; ai < 2; ++ai)
#pragma unroll
            for (int m = 0; m < 4; ++m) { bf16_t* rowp = base + (size_t)(row0 + ai * HALF + m * 16) * ldc + col0;
#pragma unroll
                for (int bj = 0; bj < 2; ++bj) { f32x4 v0 = acc[ai][bj][m][0] + bv[bj][0], v1 = acc[ai][bj][m][1] + bv[bj][1];
                    if (ACT == 1) { f32x2 a = gelu_pk((f32x2){v0[0], v0[1]}), b = gelu_pk((f32x2){v0[2], v0[3]}), c = gelu_pk((f32x2){v1[0], v1[1]}), d = gelu_pk((f32x2){v1[2], v1[3]});
                        v0 = (f32x4){a.x, a.y, b.x, b.y}; v1 = (f32x4){c.x, c.y, d.x, d.y}; }
                    v0 = v0 * sc; v1 = v1 * sc; u32x4 w; w.x = cvt_pk_bf16(v0[0], v0[1]); w.y = cvt_pk_bf16(v0[2], v0[3]); w.z = cvt_pk_bf16(v1[0], v1[1]); w.w = cvt_pk_bf16(v1[2], v1[3]);
                    *(u32x4*)(rowp + bj * HALF) = w; } }
    }
};

constexpr int ROWS_P = 16384, ROWS_S = 128, ROWS_REAL = ROWS_P + ROWS_S;
struct EpiIn {
    static constexpr bool PERM = true, AFTER_DRAIN = false;
    bf16_t* buf0; size_t bstride; float* outp; size_t o_kp, o_ks, d_p, d_s; float* kmean; float qscale;
    __device__ __forceinline__ void operator()(const f32x4 (&acc)[2][2][4][2], const Unit& u, int wr, int wc, int fr, int fq) const {
        const int t = u.pn >> 1, colt = (u.pn & 1) * BM; bf16_t* base = buf0 + (size_t)t * bstride;
        const float sc = (t == 0) ? qscale : ((t == 4) ? 0.08838834764831845f : 1.0f);
        const int col0 = colt + wc * 32 + 8 * fq, row0 = u.pm * BM + wr * 64 + fr;
        const bool kv = (t == 1 || t == 2);
        const size_t tv = (t == 2) ? 1 : 0; float* fo = outp + ((u.pm < 64) ? o_kp + tv * d_p : o_ks + tv * d_s);
#pragma unroll
        for (int ai = 0; ai < 2; ++ai)
#pragma unroll
            for (int m = 0; m < 4; ++m) { const int row = row0 + ai * HALF + m * 16; bf16_t* rowp = base + (size_t)row * 512 + col0;
                const int frow = (u.pm < 64) ? row : row - ROWS_P; const bool fok = kv && (u.pm < 64 || frow < ROWS_S);
#pragma unroll
                for (int bj = 0; bj < 2; ++bj) { const f32x4 v0 = acc[ai][bj][m][0] * sc, v1 = acc[ai][bj][m][1] * sc;
                    u32x4 w; w.x = cvt_pk_bf16(v0[0], v0[1]); w.y = cvt_pk_bf16(v0[2], v0[3]); w.z = cvt_pk_bf16(v1[0], v1[1]); w.w = cvt_pk_bf16(v1[2], v1[3]);
                    *(u32x4*)(rowp + bj * HALF) = w;
                    if (fok) { float* fp = fo + (size_t)frow * 512 + col0 + bj * HALF; *(f32x4*)fp = v0; *(f32x4*)(fp + 4) = v1; } } }
        if (t == 1 && u.pm < 64) {
#pragma unroll
            for (int bj = 0; bj < 2; ++bj)
#pragma unroll
                for (int n = 0; n < 2; ++n) { f32x4 s = (f32x4){0.f, 0.f, 0.f, 0.f};
#pragma unroll
                    for (int ai = 0; ai < 2; ++ai)
#pragma unroll
                        for (int m = 0; m < 4; ++m) s += acc[ai][bj][m][n];
#pragma unroll
                    for (int j = 0; j < 4; ++j) { float x = s[j]; x += __shfl_xor(x, 1); x += __shfl_xor(x, 2); x += __shfl_xor(x, 4); x += __shfl_xor(x, 8);
                        if (fr == 0) __hip_atomic_fetch_add(kmean + (size_t)u.pm * 512 + col0 + bj * HALF + 4 * n + j, x, __ATOMIC_RELAXED, __HIP_MEMORY_SCOPE_AGENT); } }
        }
    }
};
struct EpiRes {
    static constexpr bool PERM = false, AFTER_DRAIN = false;
    const float* resP; const float* resS; const float* mod; int goff; float* pre; float alpha;
    __device__ __forceinline__ void operator()(const f32x4 (&acc)[2][2][4][2], const Unit& u, int wr, int wc, int fr, int fq) const {
        const int col0 = u.pn * BM + wc * 32 + 4 * fq, row0 = u.pm * BM + wr * 64 + fr;
#pragma unroll
        for (int ai = 0; ai < 2; ++ai)
#pragma unroll
            for (int m = 0; m < 4; ++m) { const int row = row0 + ai * HALF + m * 16;
                if (row < ROWS_REAL) {
                    const int bi = (row < ROWS_P) ? (row >> 11) : (8 + row - ROWS_P);
                    const float* rp = (row < ROWS_P) ? resP + (size_t)row * 1024 : resS + (size_t)(row - ROWS_P) * 1024;
                    const float* gp = mod + (size_t)bi * 6144 + goff; float* op = pre + (size_t)row * 1024;
#pragma unroll
                    for (int bj = 0; bj < 2; ++bj)
#pragma unroll
                        for (int n = 0; n < 2; ++n) { const int c = col0 + bj * HALF + n * 16; const f32x4 g = *(const f32x4*)(gp + c), x = *(const f32x4*)(rp + c);
                            *(f32x4*)(op + c) = x * alpha + (g + 1.0f) * acc[ai][bj][m][n]; } } }
    }
};
struct EpiSwiglu {
    static constexpr bool PERM = true, AFTER_DRAIN = false;
    bf16_t* act; int ldc;
    __device__ __forceinline__ void operator()(const f32x4 (&acc)[2][2][4][2], const Unit& u, int wr, int wc, int fr, int fq) const {
        const int col0 = u.pn * HALF + wc * 32 + 8 * fq, row0 = u.pm * BM + wr * 64 + fr;
#pragma unroll
        for (int ai = 0; ai < 2; ++ai)
#pragma unroll
            for (int m = 0; m < 4; ++m) { const int row = row0 + ai * HALF + m * 16; float o[8];
#pragma unroll
                for (int n = 0; n < 2; ++n)
#pragma unroll
                    for (int j = 0; j < 4; ++j) { const float g = acc[ai][0][m][n][j], up = acc[ai][1][m][n][j];
                        o[4 * n + j] = g * __builtin_amdgcn_rcpf(1.0f + __builtin_amdgcn_exp2f(-1.4426950408889634f * g)) * up; }
                u32x4 w; w.x = cvt_pk_bf16(o[0], o[1]); w.y = cvt_pk_bf16(o[2], o[3]); w.z = cvt_pk_bf16(o[4], o[5]); w.w = cvt_pk_bf16(o[6], o[7]);
                *(u32x4*)(act + (size_t)row * ldc + col0) = w; }
    }
};
template <class Epi, class Sched, bool ALIGN_EPI = false, bool SP2 = false>
__device__ __forceinline__ void gemm_phase(PG8_LAS unsigned char* lds, const Gemm g, const Sched& S, const Epi& E) {
    int tid_ = threadIdx.x; asm volatile("" : "+v"(tid_));
    const int tid = tid_, wid = __builtin_amdgcn_readfirstlane(tid >> 6), lane = tid & 63, wr = wid >> 2, wc = wid & 3, fr = lane & 15, fq = lane >> 4;
    const int K = g.K, nt = K / BK;
    unsigned voffA[2], voffB[2];
#pragma unroll
    for (int i = 0; i < 2; ++i) { int R, C; stage_rc(tid * 16 + i * 8192, R, C); const int Rb = Epi::PERM ? ((R & ~31) + perm32(R & 31)) : R;
        voffA[i] = (unsigned)(R * K + C) * 2u; voffB[i] = (unsigned)(Rb * K + C) * 2u; }
    const size_t kstep = (size_t)(BK * 2);
    const size_t hstep = (size_t)HALF * K * 2;
    const size_t tstep = 2 * hstep;
    const unsigned ldsw = (unsigned)wid * 1024u;
    const int aoff = lds_byte(wr * 64 + fr, fq * 8), boff = lds_byte(wc * 32 + fr, fq * 8);
#define PG8_SA(b, h) (((b) * 2 + (h)) * HTB)
#define PG8_SB(b, h) ((4 + (b) * 2 + (h)) * HTB)
#define PG8_STAGE(bufoff, gbase, voff) do { _Pragma("unroll") for (int _i = 0; _i < 2; ++_i) \
        __builtin_amdgcn_global_load_lds((const unsigned*)((const char*)(gbase) + (voff)[_i]), (PG8_LAS unsigned*)(lds + (bufoff) + ldsw + _i * 8192), 16, 0, 0); } while (0)
#define PG8_LDA(dst, b, h) do { _Pragma("unroll") for (int m = 0; m < 4; ++m) _Pragma("unroll") for (int k = 0; k < 2; ++k) dst[m][k] = *(const PG8_LAS bf16x8*)(lds + PG8_SA(b, h) + aoff + m * 2048 + k * 1024); } while (0)
#define PG8_LDB(dst, b, h) do { _Pragma("unroll") for (int n = 0; n < 2; ++n) _Pragma("unroll") for (int k = 0; k < 2; ++k) dst[n][k] = *(const PG8_LAS bf16x8*)(lds + PG8_SB(b, h) + boff + n * 2048 + k * 1024); } while (0)
#define PG8_MMA(ai, bj, At, Bt) do { __builtin_amdgcn_s_setprio(1); _Pragma("unroll") for (int m = 0; m < 4; ++m) _Pragma("unroll") for (int n = 0; n < 2; ++n) _Pragma("unroll") for (int k = 0; k < 2; ++k) \
        acc[ai][bj][m][n] = __builtin_amdgcn_mfma_f32_16x16x32_bf16(Bt[n][k], At[m][k], acc[ai][bj][m][n], 0, 0, 0); __builtin_amdgcn_s_setprio(0); } while (0)
#define PG8_WAIT_V(n) asm volatile("s_waitcnt vmcnt(" #n ")" ::: "memory")
#define PG8_WAIT_L(n) asm volatile("s_waitcnt lgkmcnt(" #n ")" ::: "memory")
#define PG8_BAR __builtin_amdgcn_s_barrier()
#define PG8_SCHED __builtin_amdgcn_sched_barrier(0)
    Unit cur, nxt; int ui = 0;
    if (!S.next(0, cur)) return;
    f32x4 acc[2][2][4][2];
#pragma unroll
    for (int a = 0; a < 2; ++a)
#pragma unroll
        for (int b = 0; b < 2; ++b)
#pragma unroll
            for (int m = 0; m < 4; ++m)
#pragma unroll
                for (int n = 0; n < 2; ++n) acc[a][b][m][n] = (f32x4){0.f, 0.f, 0.f, 0.f};
    bf16x8 At[4][2], B0[2][2], B1[2][2];
    const char* cA = (const char*)g.A + (size_t)cur.pm * tstep; const char* cB = (const char*)g.Bt + (size_t)cur.pn * tstep;
    S.a_ready(cur);
    if constexpr (SP2) {
        PG8_STAGE(PG8_SB(0, 0), cB, voffB); PG8_STAGE(PG8_SB(0, 1), cB + hstep, voffB); PG8_STAGE(PG8_SA(0, 0), cA, voffA); PG8_STAGE(PG8_SA(0, 1), cA + hstep, voffA);
        if (wr == 1) PG8_BAR;
        PG8_WAIT_V(2); PG8_BAR;
        PG8_STAGE(PG8_SB(1, 0), cB + kstep, voffB); PG8_STAGE(PG8_SA(1, 0), cA + kstep, voffA); PG8_STAGE(PG8_SB(1, 1), cB + hstep + kstep, voffB);
        PG8_WAIT_V(6); PG8_BAR;
    } else {
        PG8_STAGE(PG8_SB(0, 0), cB, voffB); PG8_STAGE(PG8_SA(0, 0), cA, voffA); PG8_STAGE(PG8_SB(0, 1), cB + hstep, voffB); PG8_STAGE(PG8_SA(0, 1), cA + hstep, voffA);
        if (wr == 1) PG8_BAR;
        PG8_WAIT_V(4); PG8_BAR;
        PG8_STAGE(PG8_SB(1, 0), cB + kstep, voffB); PG8_STAGE(PG8_SA(1, 0), cA + kstep, voffA); PG8_STAGE(PG8_SB(1, 1), cB + hstep + kstep, voffB);
        PG8_WAIT_V(6); PG8_BAR;
    }
    for (;;) {
        const bool has_next = S.next(ui + 1, nxt);
        const char* nA = has_next ? (const char*)g.A + (size_t)nxt.pm * tstep : cA; const char* nB = has_next ? (const char*)g.Bt + (size_t)nxt.pn * tstep : cB;
        for (int t = 0; t < nt; t += 2) {
            const bool last = (t == nt - 2);
            const char* a1 = cA + (size_t)(t + 1) * kstep;
            const char* a2 = last ? nA : cA + (size_t)(t + 2) * kstep; const char* b2 = last ? nB : cB + (size_t)(t + 2) * kstep;
            const char* a3 = a2 + kstep; const char* b3 = b2 + kstep;
            if (last && has_next) S.a_ready(nxt);
            if constexpr (SP2) {
            PG8_LDB(B0, 0, 0); PG8_LDB(B1, 0, 1); PG8_SCHED; PG8_LDA(At, 0, 0); PG8_STAGE(PG8_SA(1, 1), a1 + hstep, voffA);
            PG8_WAIT_V(8); PG8_WAIT_L(0); PG8_BAR; PG8_MMA(0, 0, At, B0); PG8_MMA(0, 1, At, B1); PG8_BAR; PG8_SCHED;
            PG8_LDA(At, 0, 1); PG8_STAGE(PG8_SB(0, 0), b2, voffB); PG8_STAGE(PG8_SB(0, 1), b2 + hstep, voffB); PG8_STAGE(PG8_SA(0, 0), a2, voffA);
            PG8_WAIT_V(8); PG8_WAIT_L(0); PG8_BAR; PG8_MMA(1, 0, At, B0); PG8_MMA(1, 1, At, B1); PG8_BAR; PG8_SCHED;
            PG8_LDB(B0, 1, 0); PG8_LDB(B1, 1, 1); PG8_SCHED; PG8_LDA(At, 1, 0); PG8_STAGE(PG8_SA(0, 1), a2 + hstep, voffA);
            PG8_WAIT_V(8); PG8_WAIT_L(0); PG8_BAR; PG8_MMA(0, 0, At, B0); PG8_MMA(0, 1, At, B1); PG8_BAR; PG8_SCHED;
            PG8_LDA(At, 1, 1); PG8_STAGE(PG8_SB(1, 0), b3, voffB); PG8_STAGE(PG8_SB(1, 1), b3 + hstep, voffB); PG8_STAGE(PG8_SA(1, 0), a3, voffA);
            PG8_WAIT_V(8); PG8_WAIT_L(0); PG8_BAR; PG8_MMA(1, 0, At, B0); PG8_MMA(1, 1, At, B1); PG8_BAR; PG8_SCHED;
            } else {
            PG8_LDB(B0, 0, 0); PG8_SCHED; PG8_LDA(At, 0, 0); PG8_STAGE(PG8_SA(1, 1), a1 + hstep, voffA);
            PG8_WAIT_L(8); PG8_BAR; PG8_WAIT_L(0); PG8_MMA(0, 0, At, B0); PG8_BAR; PG8_SCHED;
            PG8_LDB(B1, 0, 1); PG8_STAGE(PG8_SB(0, 0), b2, voffB);
            PG8_BAR; PG8_WAIT_L(0); PG8_MMA(0, 1, At, B1); PG8_BAR;
            PG8_LDA(At, 0, 1); PG8_STAGE(PG8_SA(0, 0), a2, voffA);
            PG8_BAR; PG8_WAIT_L(0); PG8_MMA(1, 0, At, B0); PG8_BAR; PG8_SCHED;
            PG8_STAGE(PG8_SB(0, 1), b2 + hstep, voffB);
            PG8_WAIT_V(6); PG8_BAR; PG8_MMA(1, 1, At, B1); PG8_BAR;
            PG8_LDB(B0, 1, 0); PG8_SCHED; PG8_LDA(At, 1, 0); PG8_STAGE(PG8_SA(0, 1), a2 + hstep, voffA);
            PG8_WAIT_L(8); PG8_BAR; PG8_WAIT_L(0); PG8_MMA(0, 0, At, B0); PG8_BAR; PG8_SCHED;
            PG8_LDB(B1, 1, 1); PG8_STAGE(PG8_SB(1, 0), b3, voffB);
            PG8_BAR; PG8_WAIT_L(0); PG8_MMA(0, 1, At, B1); PG8_BAR;
            PG8_LDA(At, 1, 1); PG8_STAGE(PG8_SA(1, 0), a3, voffA);
            PG8_BAR; PG8_WAIT_L(0); PG8_MMA(1, 0, At, B0); PG8_BAR; PG8_SCHED;
            PG8_STAGE(PG8_SB(1, 1), b3 + hstep, voffB);
            PG8_WAIT_V(6); PG8_BAR; PG8_MMA(1, 1, At, B1); PG8_BAR;
            }
        }
        if constexpr (ALIGN_EPI) { if (wr == 0) PG8_BAR; }
        if constexpr (!Epi::AFTER_DRAIN) { E(acc, cur, wr, wc, fr, fq); S.done(cur); }
        if (!has_next) break;
#pragma unroll
        for (int a = 0; a < 2; ++a)
#pragma unroll
            for (int b = 0; b < 2; ++b)
#pragma unroll
                for (int m = 0; m < 4; ++m)
#pragma unroll
                    for (int n = 0; n < 2; ++n) acc[a][b][m][n] = (f32x4){0.f, 0.f, 0.f, 0.f};
        cur = nxt; cA = nA; cB = nB; ++ui;
        if constexpr (ALIGN_EPI) { if (wr == 1) PG8_BAR; }
    }
    PG8_WAIT_V(0);
    if constexpr (!ALIGN_EPI) { if (wr == 0) PG8_BAR; }
    PG8_BAR;
    if constexpr (Epi::AFTER_DRAIN) { E.fused(acc, cur, wr, wc, fr, fq, lds, wid, lane); S.done(cur); }
#undef PG8_SA
#undef PG8_SB
#undef PG8_STAGE
#undef PG8_LDA
#undef PG8_LDB
#undef PG8_MMA
#undef PG8_WAIT_V
#undef PG8_WAIT_L
#undef PG8_BAR
#undef PG8_SCHED
}
}
#include <hip/hip_bf16.h>
#include <cmath>
namespace attn_body {
using bf16=__hip_bfloat16;
using bf16x8=__attribute__((ext_vector_type(8)))short;
using s16x4=__attribute__((ext_vector_type(4)))short;
using f32x16=__attribute__((ext_vector_type(16)))float;
using u32x4=__attribute__((ext_vector_type(4)))unsigned;
constexpr int BATCH=8,NHEAD=8,SEQ=2048,D=64,DM=NHEAD*D,OPITCH=1024;
constexpr int NW=8,QBLK=32,QB=QBLK*NW,KVBLK=64,NQB=SEQ/QB;
constexpr int ATTN_PITCH=DM, ATTN_UNIT_ROWS=QB;
__device__ __forceinline__ int crow(int r,int hi){return (r&3)+8*(r>>2)+4*hi;}
#define SBAR() __builtin_amdgcn_sched_barrier(0)
__device__ __forceinline__ void cmask(f32x16&p0,f32x16&p1,int jb,int qrel,int hi){
  const float NEG=-INFINITY; int kb=64*jb+4*hi;
  #pragma unroll
  for(int r=0;r<16;++r){int kv=kb+(r&3)+8*(r>>2); if(kv>qrel)p0[r]=NEG; if(kv+32>qrel)p1[r]=NEG;}
}

__device__ __forceinline__ void smask(f32x16&p0,f32x16&p1,bool keep){
  const float NEG=-INFINITY;
  #pragma unroll
  for(int r=0;r<16;++r){p0[r]=keep?p0[r]:NEG;p1[r]=keep?p1[r]:NEG;}
}
using f32x4v=__attribute__((ext_vector_type(4)))float;
__device__ __forceinline__ float bf2f(short v){return __uint_as_float(((unsigned)(unsigned short)v)<<16);}
constexpr int NSLOT=3, SLOTB=8192;
constexpr int LDS_K=0, LDS_V=NSLOT*SLOTB, LDS_WS=2*NSLOT*SLOTB, LDS_OST=LDS_WS+NW*64*4, LDS_BYTES=LDS_OST+NW*4096;
constexpr float C2=0.125f*1.4426950408889634f;
__device__ __forceinline__ void glds16(const void*gsrc,unsigned lds_dst){unsigned keep;
  asm volatile("s_mov_b32 %0, m0\n\ts_mov_b32 m0, %2\n\ts_nop 0\n\tglobal_load_lds_dwordx4 %1, off\n\ts_mov_b32 m0, %0":"=&s"(keep):"v"(gsrc),"s"(lds_dst):"memory");}
__device__ __forceinline__ float max3f(float a,float b,float c){float r;asm("v_max3_f32 %0, %1, %2, %3":"=v"(r):"v"(a),"v"(b),"v"(c));return r;}
__device__ __forceinline__ float max2f(float a,float b){float r;asm("v_max_f32_e32 %0, %1, %2":"=v"(r):"v"(a),"v"(b));return r;}
__device__ __forceinline__ float fadd_s(float a,float b){float r;asm("v_add_f32_e32 %0, %1, %2":"=v"(r):"v"(a),"v"(b));return r;}
__device__ __forceinline__ float fsub_s(float a,float b){float r;asm("v_sub_f32_e32 %0, %1, %2":"=v"(r):"v"(a),"v"(b));return r;}
typedef float f32x2_t __attribute__((ext_vector_type(2))); typedef __bf16 bf16x2_t __attribute__((ext_vector_type(2)));
__device__ __forceinline__ unsigned cvtpk_s(float lo,float hi){f32x2_t v={lo,hi};bf16x2_t b=__builtin_convertvector(v,bf16x2_t);return __builtin_bit_cast(unsigned,b);}
#define WAIT_BAR(N) asm volatile("s_waitcnt vmcnt(" #N ") lgkmcnt(0)\n\ts_barrier":::"memory")

__device__ __forceinline__ void qkt(f32x16&p0,f32x16&p1,const char*Kslot,const bf16x8*qr,const f32x16&negm,int r32,int hi){
  const char*kb=Kslot+hi*1024+r32*16;
  #pragma unroll
  for(int d0=0;d0<4;++d0){
    const bf16x8 b0=*reinterpret_cast<const bf16x8*>(kb+d0*2048);
    const bf16x8 b1=*reinterpret_cast<const bf16x8*>(kb+d0*2048+512);
    if(d0==0){p0=__builtin_amdgcn_mfma_f32_32x32x16_bf16(b0,qr[0],negm,0,0,0);p1=__builtin_amdgcn_mfma_f32_32x32x16_bf16(b1,qr[0],negm,0,0,0);}
    else{p0=__builtin_amdgcn_mfma_f32_32x32x16_bf16(b0,qr[d0],p0,0,0,0);p1=__builtin_amdgcn_mfma_f32_32x32x16_bf16(b1,qr[d0],p1,0,0,0);}}
}
typedef __attribute__((address_space(3))) const char* lds_cptr;
typedef short v4i16_t __attribute__((ext_vector_type(4)));
__device__ __forceinline__ void kload8(bf16x8*kf,lds_cptr kp){
  kf[0]=*(const __attribute__((address_space(3))) bf16x8*)(kp);      kf[1]=*(const __attribute__((address_space(3))) bf16x8*)(kp+512);
  kf[2]=*(const __attribute__((address_space(3))) bf16x8*)(kp+2048); kf[3]=*(const __attribute__((address_space(3))) bf16x8*)(kp+2560);
  kf[4]=*(const __attribute__((address_space(3))) bf16x8*)(kp+4096); kf[5]=*(const __attribute__((address_space(3))) bf16x8*)(kp+4608);
  kf[6]=*(const __attribute__((address_space(3))) bf16x8*)(kp+6144); kf[7]=*(const __attribute__((address_space(3))) bf16x8*)(kp+6656);
}
__device__ __forceinline__ void kload2(bf16x8*kf,lds_cptr kp,int j){ kf[2*j]=*(const __attribute__((address_space(3))) bf16x8*)(kp+j*2048); kf[2*j+1]=*(const __attribute__((address_space(3))) bf16x8*)(kp+j*2048+512); }
__device__ __forceinline__ s16x4 vtr(lds_cptr p){ return __builtin_bit_cast(s16x4,__builtin_amdgcn_ds_read_tr16_b64_v4i16((__attribute__((address_space(3))) v4i16_t*)p)); }
__device__ __forceinline__ float rowmax(const f32x16&p0,const f32x16&p1){
  float a=max3f(p0[0],p0[1],p1[0]),b=max3f(p0[2],p0[3],p1[1]);a=max3f(a,p1[2],p1[3]);
  #pragma unroll
  for(int r=4;r<16;r+=4){a=max3f(a,p0[r],p0[r+1]);b=max3f(b,p0[r+2],p0[r+3]);a=max3f(a,p1[r],p1[r+1]);b=max3f(b,p1[r+2],p1[r+3]);}
  const float m=max2f(a,b);
  auto rr=__builtin_amdgcn_permlane32_swap(__float_as_uint(m),__float_as_uint(m),false,false);
  return max2f(__uint_as_float(rr[0]),__uint_as_float(rr[1]));
}
__device__ __forceinline__ void pv(f32x16*o,int vb,bf16x8 pa0,bf16x8 pa1,bf16x8 pa2,bf16x8 pa3){
  #pragma unroll
  for(int d0=0;d0<2;++d0){s16x4 lo[4],hi[4];
    #pragma unroll
    for(int ks=0;ks<4;++ks){
      asm volatile("ds_read_b64_tr_b16 %0,%1 offset:%c2":"=&v"(lo[ks]):"v"(vb),"i"(d0*4096+ks*1024):"memory");
      asm volatile("ds_read_b64_tr_b16 %0,%1 offset:%c2":"=&v"(hi[ks]):"v"(vb),"i"(d0*4096+ks*1024+512):"memory");}
    asm volatile("s_waitcnt lgkmcnt(0)":::"memory");SBAR();
    #define PK(k) (bf16x8){lo[k][0],lo[k][1],lo[k][2],lo[k][3],hi[k][0],hi[k][1],hi[k][2],hi[k][3]}
    o[d0]=__builtin_amdgcn_mfma_f32_32x32x16_bf16(pa0,PK(0),o[d0],0,0,0);
    o[d0]=__builtin_amdgcn_mfma_f32_32x32x16_bf16(pa1,PK(1),o[d0],0,0,0);
    o[d0]=__builtin_amdgcn_mfma_f32_32x32x16_bf16(pa2,PK(2),o[d0],0,0,0);
    o[d0]=__builtin_amdgcn_mfma_f32_32x32x16_bf16(pa3,PK(3),o[d0],0,0,0);
    #undef PK
  }
}

#ifndef ATTN_STORE16
#define ATTN_STORE16(p,v) (*(u32x4*)(p)=(v))
#endif
template<int THRL> __device__ __forceinline__ void attn_unit(int b,int h,int qb,const bf16*Q,const bf16*__restrict__ K,const bf16*__restrict__ V,bf16*O,const float*__restrict__ KM,char*shm){
  int tid_=threadIdx.x; asm volatile("":"+v"(tid_)); const int tid=tid_,lane=tid&63,r32=lane&31,hi=lane>>5; const int wid=__builtin_amdgcn_readfirstlane(tid>>6);
  const long rowbase=(long)b*SEQ; const int q0=qb*QB;
  const bf16*Qw=Q+(rowbase+q0+wid*QBLK)*DM+h*D;
  const bf16*Kh=K+rowbase*DM+h*D,*Vh=V+rowbase*DM+h*D;
  const unsigned lds0=(unsigned)(uintptr_t)shm;
  float*wsf=(float*)(shm+LDS_WS)+wid*64;
  const bf16*ksrc=Kh+(long)lane*DM+wid*8;
  const bf16*vsrc=Vh+(long)(16*(wid&3)+(lane>>2))*DM+(wid>>2)*32+(lane&3)*8;
  const unsigned kdst=lds0+LDS_K+wid*1024, vdst=lds0+LDS_V+wid*1024;
  #define DMA_K(t,slot) glds16(ksrc+(long)(t)*KVBLK*DM,(unsigned)__builtin_amdgcn_readfirstlane(kdst+(slot)))
  #define DMA_V(t,slot) glds16(vsrc+(long)(t)*KVBLK*DM,(unsigned)__builtin_amdgcn_readfirstlane(vdst+(slot)))
  const int vb0=(int)(lds0+LDS_V)+((lane>>4)&1)*32+(lane&3)*8+(4*hi+((lane&15)>>2))*64;
  const char*Kbase=shm+LDS_K; bf16x8 kf[8];
  const lds_cptr shm3=(lds_cptr)shm; const lds_cptr kp0=shm3+LDS_K+hi*1024+r32*16; const lds_cptr vp0=shm3+LDS_V+((lane>>4)&1)*32+(lane&3)*8+(4*hi+((lane&15)>>2))*64;
  const int NT=(q0+QB)/KVBLK;
  DMA_K(0,0);DMA_V(0,0);DMA_K(1,SLOTB);
  bf16x8 qr[4];
  #pragma unroll
  for(int d0=0;d0<4;++d0)qr[d0]=*reinterpret_cast<const bf16x8*>(&Qw[(long)r32*DM+d0*16+hi*8]);
  unsigned selm=0u;
  { float sc[7];
    #pragma unroll
    for(int n=0;n<7;++n){ float a=0.f;
      if(n<qb){ const float*km=KM+((long)(b*8+n)*DM+h*D+hi*8);
        #pragma unroll
        for(int d0=0;d0<4;++d0){ const f32x4v k0=*reinterpret_cast<const f32x4v*>(km+d0*16),k1=*reinterpret_cast<const f32x4v*>(km+d0*16+4);
          a+=bf2f(qr[d0][0])*k0[0]+bf2f(qr[d0][1])*k0[1]+bf2f(qr[d0][2])*k0[2]+bf2f(qr[d0][3])*k0[3]+bf2f(qr[d0][4])*k1[0]+bf2f(qr[d0][5])*k1[1]+bf2f(qr[d0][6])*k1[2]+bf2f(qr[d0][7])*k1[3]; }
        a+=__shfl_xor(a,32); }
      sc[n]=a; }
    #pragma unroll
    for(int n=0;n<7;++n){ int rank=0;
      #pragma unroll
      for(int n2=0;n2<7;++n2){ if(n2!=n){ const bool gt=(n2<n)?(sc[n2]>=sc[n]):(sc[n2]>sc[n]); rank+=(n2<qb&&gt)?1:0; } }
      if(n<qb&&rank<3)selm|=(1u<<n); } }
  float mhat=0.f,l_reg=0.f;f32x16 o[2];o[0]=f32x16{};o[1]=f32x16{};f32x16 negm=f32x16{};asm volatile("":"+v"(negm));
  const int qrel=wid*QBLK+r32;
  #define CMASK(P0,P1,t) do{int jb_=(t)-(NT-4); if(jb_>=0)cmask(P0,P1,jb_,qrel,hi); else smask(P0,P1,((selm>>((t)>>2))&1u)!=0u);}while(0)
  bool resc=false;
  #define START(P0,P1) do{ const float rm=__builtin_fmaxf(rowmax(P0,P1),-64.f); resc=false; \
    { const float dl=rm; mhat=fadd_s(mhat,dl); \
      _Pragma("unroll") for(int r=0;r<16;++r){P0[r]=fsub_s(P0[r],dl);P1[r]=fsub_s(P1[r],dl);} \
      _Pragma("unroll") for(int r=0;r<16;++r)negm[r]=-mhat; asm volatile("":"+v"(negm)); } \
    _Pragma("unroll") for(int r=0;r<16;++r)P0[r]=__builtin_amdgcn_exp2f(P0[r]); }while(0)
  #define RESC() do{ if(resc){ asm volatile("s_waitcnt lgkmcnt(0)":::"memory"); \
      _Pragma("unroll") for(int d_=0;d_<2;++d_) _Pragma("unroll") for(int r=0;r<16;++r)o[d_][r]*=wsf[crow(r,hi)]; } }while(0)
  f32x16 pA0,pA1,pB0,pB1;
  int sl_prev=0,sl_cur=0,sl_next=SLOTB;
  #define ROT() do{sl_prev=sl_cur;sl_cur=sl_next;sl_next=(sl_next==(NSLOT-1)*SLOTB)?0:sl_next+SLOTB;}while(0)
  DMA_K(2,2*SLOTB);
  WAIT_BAR(3);
  qkt(pA0,pA1,Kbase,qr,negm,r32,hi);asm volatile("s_nop 15\n\ts_nop 7":"+v"(pA0),"+v"(pA1));CMASK(pA0,pA1,0);
  START(pA0,pA1);
  _Pragma("unroll") for(int r=0;r<16;++r)pA1[r]=__builtin_amdgcn_exp2f(pA1[r]);
  WAIT_BAR(0);
  DMA_K(3,0);DMA_V(1,SLOTB);
  ROT();
  kload8(kf,kp0+sl_cur);
  WAIT_BAR(2);
  s16x4 vlo[8],vhi[8]; u32x4 pw0,pw1,pw2,pw3;
  #define PKW(P,B) cvtpk_s(P[B],P[B+1])
  #define PAF(k) __builtin_bit_cast(bf16x8,pw##k)
  #define VFR(i) (bf16x8){vlo[i][0],vlo[i][1],vlo[i][2],vlo[i][3],vhi[i][0],vhi[i][1],vhi[i][2],vhi[i][3]}
  #define PIN(x) asm volatile("":"+v"(x))
  #define MX3(a,b,c) __builtin_fmaxf(__builtin_fmaxf((a),(b)),(c))
  #define GAPA(MF,A0,A1,A2,A3,W0,W1,PW) do{ MF; sacc+=A0; sacc+=A1; sacc+=A2; sacc+=A3; PIN(sacc); W0; W1; PIN(PW); SBAR(); }while(0)
  #define EX(v) __builtin_amdgcn_exp2f(v)
  #define GAPB(MF,X,B) do{ MF; X[B]=EX(X[B]); X[B+1]=EX(X[B+1]); X[B+2]=EX(X[B+2]); X[B+3]=EX(X[B+3]); PIN(X); SBAR(); }while(0)
  #define VRD(i) do{ vlo[i]=vtr(vp_+(((i)>>2)*4096+((i)&3)*1024)); vhi[i]=vtr(vp_+(((i)>>2)*4096+((i)&3)*1024+512)); }while(0)
  #define KRD(G,j) do{ if(G){ kload2(kf,kp0+sl_next,j); SBAR(); } }while(0)
  #define STEP(C0,C1,P0,P1,t,GK,GV,GL) do{ SBAR(); \
    const lds_cptr vp_=vp0+sl_prev; \
    VRD(0); SBAR(); float sacc=(P0[0]+P0[1]); \
    GAPA(C0=__builtin_amdgcn_mfma_f32_32x32x16_bf16(kf[0],qr[0],negm,0,0,0), P0[2],P0[3],P0[4],P0[5],     pw0[0]=PKW(P0,0), pw0[1]=PKW(P0,2), pw0); \
    VRD(4); SBAR(); GAPA(C1=__builtin_amdgcn_mfma_f32_32x32x16_bf16(kf[1],qr[0],negm,0,0,0), P0[6],P0[7],P0[8],P0[9],     pw0[2]=PKW(P0,4), pw0[3]=PKW(P0,6), pw0); \
    VRD(1); SBAR(); GAPA(C0=__builtin_amdgcn_mfma_f32_32x32x16_bf16(kf[2],qr[1],C0,0,0,0),   P0[10],P0[11],P0[12],P0[13], pw1[0]=PKW(P0,8), pw1[1]=PKW(P0,10), pw1); \
    VRD(5); SBAR(); GAPA(C1=__builtin_amdgcn_mfma_f32_32x32x16_bf16(kf[3],qr[1],C1,0,0,0),   P0[14],P0[15],P1[0],P1[1],   pw1[2]=PKW(P0,12),pw1[3]=PKW(P0,14), pw1); \
    VRD(2); SBAR(); GAPA(C0=__builtin_amdgcn_mfma_f32_32x32x16_bf16(kf[4],qr[2],C0,0,0,0),   P1[2],P1[3],P1[4],P1[5],     pw2[0]=PKW(P1,0), pw2[1]=PKW(P1,2), pw2); \
    VRD(6); SBAR(); GAPA(C1=__builtin_amdgcn_mfma_f32_32x32x16_bf16(kf[5],qr[2],C1,0,0,0),   P1[6],P1[7],P1[8],P1[9],     pw2[2]=PKW(P1,4), pw2[3]=PKW(P1,6), pw2); \
    VRD(3); SBAR(); GAPA(C0=__builtin_amdgcn_mfma_f32_32x32x16_bf16(kf[6],qr[3],C0,0,0,0),   P1[10],P1[11],P1[12],P1[13], pw3[0]=PKW(P1,8), pw3[1]=PKW(P1,10), pw3); \
    VRD(7); SBAR(); GAPA(C1=__builtin_amdgcn_mfma_f32_32x32x16_bf16(kf[7],qr[3],C1,0,0,0),   P1[14],P1[15],0.f,0.f,       pw3[2]=PKW(P1,12),pw3[3]=PKW(P1,14), pw3); \
    l_reg+=sacc; \
    if(GK){DMA_K((t)+3,sl_cur);} if(GV){DMA_V((t)+1,sl_next);} \
    CMASK(C0,C1,t); \
    { float a=MX3(C0[0],C0[1],C1[0]),b=MX3(C0[2],C0[3],C1[1]); a=MX3(a,C1[2],C1[3]); \
      _Pragma("unroll") for(int r=4;r<16;r+=4){a=MX3(a,C0[r],C0[r+1]);b=MX3(b,C0[r+2],C0[r+3]);a=MX3(a,C1[r],C1[r+1]);b=MX3(b,C1[r+2],C1[r+3]);} \
      float rm=__builtin_fmaxf(a,b); { auto rr=__builtin_amdgcn_permlane32_swap(__float_as_uint(rm),__float_as_uint(rm),false,false); rm=__builtin_fmaxf(__uint_as_float(rr[0]),__uint_as_float(rr[1])); } \
      resc=false; \
      if(__builtin_expect(__any(rm>(float)THRL),0)){ const float dl=__builtin_fmaxf(rm,0.f); mhat+=dl; \
        _Pragma("unroll") for(int r=0;r<16;++r){C0[r]-=dl;C1[r]-=dl;} \
        _Pragma("unroll") for(int r=0;r<16;++r)negm[r]=-mhat; asm volatile("":"+v"(negm)); \
        const float f=__builtin_amdgcn_exp2f(-dl); l_reg*=f; if(hi==0)wsf[r32]=f; resc=true; } } \
    SBAR(); \
    GAPB(o[0]=__builtin_amdgcn_mfma_f32_32x32x16_bf16(PAF(0),VFR(0),o[0],0,0,0), C0,0); \
    GAPB(o[1]=__builtin_amdgcn_mfma_f32_32x32x16_bf16(PAF(0),VFR(4),o[1],0,0,0), C0,4); \
    KRD(GL,0); GAPB(o[0]=__builtin_amdgcn_mfma_f32_32x32x16_bf16(PAF(1),VFR(1),o[0],0,0,0), C0,8); \
    KRD(GL,1); GAPB(o[1]=__builtin_amdgcn_mfma_f32_32x32x16_bf16(PAF(1),VFR(5),o[1],0,0,0), C0,12); \
    KRD(GL,2); GAPB(o[0]=__builtin_amdgcn_mfma_f32_32x32x16_bf16(PAF(2),VFR(2),o[0],0,0,0), C1,0); \
    KRD(GL,3); GAPB(o[1]=__builtin_amdgcn_mfma_f32_32x32x16_bf16(PAF(2),VFR(6),o[1],0,0,0), C1,4); \
    GAPB(o[0]=__builtin_amdgcn_mfma_f32_32x32x16_bf16(PAF(3),VFR(3),o[0],0,0,0), C1,8); \
    GAPB(o[1]=__builtin_amdgcn_mfma_f32_32x32x16_bf16(PAF(3),VFR(7),o[1],0,0,0), C1,12); \
    }while(0)
  int t=1;
  #undef CMASK
  #define CMASK(P0,P1,t) do{ smask(P0,P1,((selm>>((t)>>2))&1u)!=0u); }while(0)
  for(;t+5<NT;t+=2){
    STEP(pB0,pB1,pA0,pA1,t,true,true,true);     WAIT_BAR(2); RESC(); ROT();
    STEP(pA0,pA1,pB0,pB1,t+1,true,true,true);   WAIT_BAR(2); RESC(); ROT();
  }
  #undef CMASK
  #define CMASK(P0,P1,t) do{int jb_=(t)-(NT-4); if(jb_>=0)cmask(P0,P1,jb_,qrel,hi); else smask(P0,P1,((selm>>((t)>>2))&1u)!=0u);}while(0)
  #define ENDW(tt) do{ if((tt)+3<NT){WAIT_BAR(2);} else if((tt)+2<NT){WAIT_BAR(1);} else {WAIT_BAR(0);} }while(0)
  for(;t+1<NT;t+=2){
    STEP(pB0,pB1,pA0,pA1,t,(t+3<NT),(t+1<NT),(t+1<NT));       ENDW(t);   RESC(); ROT();
    STEP(pA0,pA1,pB0,pB1,t+1,(t+4<NT),(t+2<NT),(t+2<NT));     ENDW(t+1); RESC(); ROT();
  }
  STEP(pB0,pB1,pA0,pA1,NT-1,false,false,false); RESC();
  { float sacc=pB0[0]+pB0[1]; _Pragma("unroll") for(int r=2;r<16;++r)sacc+=pB0[r]; _Pragma("unroll") for(int r=0;r<16;++r)sacc+=pB1[r]; l_reg+=sacc;
    pw0=(u32x4){PKW(pB0,0),PKW(pB0,2),PKW(pB0,4),PKW(pB0,6)};pw1=(u32x4){PKW(pB0,8),PKW(pB0,10),PKW(pB0,12),PKW(pB0,14)};pw2=(u32x4){PKW(pB1,0),PKW(pB1,2),PKW(pB1,4),PKW(pB1,6)};pw3=(u32x4){PKW(pB1,8),PKW(pB1,10),PKW(pB1,12),PKW(pB1,14)};
    SBAR(); pv(o,vb0+sl_cur,PAF(0),PAF(1),PAF(2),PAF(3)); }
  #undef PKW
  #undef PAF
  #undef VFR
  #undef PIN
  #undef MX3
  #undef GAPA
  #undef GAPB
  #undef EX
  #undef VRD
  #undef KRD
  #undef STEP
  #undef ENDW
  {auto rr=__builtin_amdgcn_permlane32_swap(__float_as_uint(l_reg),__float_as_uint(l_reg),false,false);l_reg=__uint_as_float(rr[0])+__uint_as_float(rr[1]);}
  if(hi==0)wsf[32+r32]=l_reg;asm volatile("s_waitcnt lgkmcnt(0)":::"memory");
  float rli[16];
  #pragma unroll
  for(int r=0;r<16;++r)rli[r]=__builtin_amdgcn_rcpf(wsf[32+crow(r,hi)]);
  bf16*Ow=O+(rowbase+q0+wid*QBLK)*OPITCH+h*D;
  { bf16*stg=(bf16*)(shm+LDS_OST)+wid*2048;
    #pragma unroll
    for(int r=0;r<16;++r){const int orow=crow(r,hi);
      #pragma unroll
      for(int d0=0;d0<2;++d0)stg[orow*64+d0*32+r32]=__float2bfloat16(o[d0][r]*rli[r]);}
    asm volatile("s_waitcnt lgkmcnt(0)":::"memory");
    #pragma unroll
    for(int i=0;i<4;++i){const int row=i*8+(lane>>3),ch=lane&7; const u32x4 v=*(const u32x4*)(stg+row*64+ch*8); ATTN_STORE16(Ow+(long)row*OPITCH+ch*8,v);} }
  asm volatile("s_waitcnt lgkmcnt(0)\n\ts_barrier":::"memory");
  #undef DMA_K
  #undef DMA_V
  #undef CMASK
  #undef START
  #undef RESC
  #undef ROT
}
constexpr int ATTN_LDS_BYTES=LDS_BYTES;
#undef SBAR
#undef WAIT_BAR
}
#define GAS __attribute__((address_space(1)))
#define LAS __attribute__((address_space(3)))
typedef unsigned short bf16;
typedef unsigned v4u __attribute__((ext_vector_type(4)));
typedef float f32x4 __attribute__((ext_vector_type(4)));
typedef short bf16x8 __attribute__((ext_vector_type(8)));
typedef GAS unsigned gu32;
typedef GAS unsigned long long gu64;
#define RLX_AGENT __ATOMIC_RELAXED, __HIP_MEMORY_SCOPE_AGENT
#define LDS_WAIT() asm volatile("s_waitcnt lgkmcnt(0)" ::: "memory")
#define VM_WAIT() asm volatile("s_waitcnt vmcnt(0)" ::: "memory")
__device__ __forceinline__ unsigned long long rt() { return __builtin_amdgcn_s_memrealtime(); }
__device__ __forceinline__ unsigned f2bf(float f) { unsigned u = __builtin_bit_cast(unsigned, f); return (u + 0x7fffu + ((u >> 16) & 1u)) >> 16; }
__device__ __forceinline__ unsigned pk2(float lo, float hi) { return f2bf(lo) | (f2bf(hi) << 16); }

#define XB_TMO      128
#define XB_XCNT(j)  (256  + 64 * (j))
#define XB_XSUB(j)  (1280 + 64 * (j))
#define XB_XGEN(j)  (2304 + 64 * (j))
#define XB_TOP      3328
#define XB_TOPGEN   3392
#define XCD_BAR_WORDS 3456
#define XB_SPIN_CAP (1u << 18)

__device__ __forceinline__ unsigned xb_ld(unsigned* p)              { return __hip_atomic_load(p, __ATOMIC_RELAXED, __HIP_MEMORY_SCOPE_AGENT); }
__device__ __forceinline__ unsigned xb_add(unsigned* p, unsigned v) { return __hip_atomic_fetch_add(p, v, __ATOMIC_RELAXED, __HIP_MEMORY_SCOPE_AGENT); }
__device__ __forceinline__ unsigned xb_xcc_id() { return (unsigned)__builtin_amdgcn_s_getreg((3 << 11) | 20) & 0xFu; }
#define XB_SPIN(cond, bar) do { unsigned _sp = 0; while (cond) { __builtin_amdgcn_s_sleep(1); \
    if ((++_sp & 255u) == 0u) { if (xb_ld(&(bar)[XB_TMO])) break; if (_sp > XB_SPIN_CAP) { atomicAdd(&(bar)[XB_TMO], 1u); break; } } } } while (0)

struct XcdBarrier {
    unsigned* bar; unsigned x;
    volatile LAS unsigned* st;
};

__device__ __forceinline__ XcdBarrier xcd_barrier_post(unsigned* bar, volatile LAS unsigned* st) {
    XcdBarrier b; b.bar = bar; b.x = xb_xcc_id(); b.st = st;
    if (threadIdx.x == 0) (void)xb_add(&bar[XB_XCNT(b.x)], 1u);
    return b;
}
__device__ __forceinline__ void xcd_barrier_complete(unsigned* bar, unsigned x, unsigned& nloc, unsigned& nx) {
    const unsigned G = gridDim.x * gridDim.y * gridDim.z;
    unsigned sum, cnt, mine, sp = 0u;
    for (;;) {
        sum = 0u; cnt = 0u; mine = 0u;
#pragma unroll
        for (unsigned j = 0; j < 16; ++j) { const unsigned c = xb_ld(&bar[XB_XCNT(j)]); sum += c; cnt += (c > 0u) ? 1u : 0u; mine = (j == x) ? c : mine; }
        if (sum == G) break;
        __builtin_amdgcn_s_sleep(1);
        if ((++sp & 255u) == 0u) { if (xb_ld(&bar[XB_TMO])) break; if (sp > XB_SPIN_CAP) { atomicAdd(&bar[XB_TMO], 1u); break; } }
    }
    nloc = mine > 0u ? mine : 1u; nx = cnt > 0u ? cnt : 1u;
}

__device__ __forceinline__ void xcd_barrier(const XcdBarrier& b) {
    asm volatile("s_waitcnt vmcnt(0)" ::: "memory");
    __syncthreads();
    if (threadIdx.x == 0) {
        unsigned* bar = b.bar;
        __builtin_amdgcn_s_waitcnt(0);
        unsigned nloc = b.st[0], nx = b.st[1];
        if (nloc == 0u) { xcd_barrier_complete(bar, b.x, nloc, nx); b.st[0] = nloc; b.st[1] = nx; }
        const unsigned old = xb_add(&bar[XB_XSUB(b.x)], 1u);
        const unsigned gen = old / nloc;
        if (old + 1u == (gen + 1u) * nloc) {
            __builtin_amdgcn_fence(__ATOMIC_RELEASE, "agent");
            asm volatile("s_waitcnt vmcnt(0)" ::: "memory");
            const unsigned og = xb_add(&bar[XB_TOP], 1u);
            const unsigned tg = og / nx;
            if (og + 1u == (tg + 1u) * nx) xb_add(&bar[XB_TOPGEN], 1u);
            else XB_SPIN(xb_ld(&bar[XB_TOPGEN]) == tg, bar);
            __builtin_amdgcn_fence(__ATOMIC_ACQUIRE, "agent");
            xb_add(&bar[XB_XGEN(b.x)], 1u);
            asm volatile("s_waitcnt vmcnt(0)" ::: "memory");
        } else {
            XB_SPIN(xb_ld(&bar[XB_XGEN(b.x)]) == gen, bar);
            __builtin_amdgcn_fence(__ATOMIC_ACQUIRE, "agent");
            asm volatile("s_waitcnt vmcnt(0)" ::: "memory");
        }
    }
    __syncthreads();
}

constexpr int D = 1024, BATCH = 8, SEQ = 2048, ROWS_P = 16384, ROWS_S = 128, ROWS_REAL = 16512, M_PAD = 16640;
constexpr int AW = 512, NIN = 3584, IN_COLS = 3592, DFF = 2816, NGU = 5632, NMOD = 6144, NBI = 136;
constexpr float LN_EPS = 1e-5f, ALPHA = 1.189207115002721f, LOG2E = 1.4426950408889634f;
constexpr float C2Q = 0.125f * 1.4426950408889634f;
typedef float f32x4v __attribute__((ext_vector_type(4)));
typedef float f32x16v __attribute__((ext_vector_type(16)));
typedef short s16x4v __attribute__((ext_vector_type(4)));
__device__ __forceinline__ float bf2f(unsigned short v) { return __uint_as_float(((unsigned)v) << 16); }
__device__ __forceinline__ float wave_sum(float v) {
#pragma unroll
    for (int o = 1; o < 64; o <<= 1) v += __shfl_xor(v, o);
    return v;
}
__device__ __forceinline__ float wave_max(float v) {
#pragma unroll
    for (int o = 1; o < 64; o <<= 1) v = fmaxf(v, __shfl_xor(v, o));
    return v;
}
__device__ __forceinline__ unsigned cvtpk(float lo, float hi) { unsigned r; asm volatile("v_cvt_pk_bf16_f32 %0, %1, %2" : "=v"(r) : "v"(lo), "v"(hi)); return r; }
__device__ __forceinline__ int crow16(int r, int hi) { return (r & 3) + 8 * (r >> 2) + 4 * hi; }

namespace ml {
typedef short v4i16_t __attribute__((ext_vector_type(4)));
constexpr int BUFB = 32768, VOFF = 16384, STG_W = 16896, G2_OFF = 8 * STG_W, DEN_OFF = G2_OFF + 8192, ML_LDS = DEN_OFF + 1024;
__device__ __forceinline__ s16x4v vtr(const LAS unsigned char* p) { return __builtin_bit_cast(s16x4v, __builtin_amdgcn_ds_read_tr16_b64_v4i16((LAS v4i16_t*)p)); }
template <bool STATE>
__device__ __forceinline__ void mlstm_unit(int b, int h, int c, const bf16* __restrict__ MQ, const bf16* __restrict__ MK, const bf16* __restrict__ MV, const bf16* __restrict__ MO,
                                           const float* __restrict__ G2, const float* __restrict__ U2, const float* __restrict__ Mm, const float* __restrict__ gnorm,
                                           bf16* MIX, float* Cout, float* nout, float* mout, LAS unsigned char* lds) {
    int tid_ = threadIdx.x; asm volatile("" : "+v"(tid_)); const int tid = tid_, lane = tid & 63, r32 = lane & 31, hi = lane >> 5; const int wid = __builtin_amdgcn_readfirstlane(tid >> 6);
    const int s = b * 4 + h; const long rowbase = (long)b * SEQ;
    const int NT = STATE ? 32 : 4 * (c + 1);
    LAS float* g2l = (LAS float*)(lds + G2_OFF);
    for (int i = tid; i < 64 * NT; i += 512) g2l[i] = G2[s * 2048 + i];
    bf16x8 qr[8]; float U;
    if (STATE) { const int dsel = 32 * (wid & 3) + r32;
#pragma unroll
        for (int d0 = 0; d0 < 8; ++d0)
#pragma unroll
            for (int e = 0; e < 8; ++e) qr[d0][e] = (16 * d0 + 8 * hi + e == dsel) ? (short)0x3F80 : (short)0;
        U = U2[s * 2048 + 2047];
    } else { const bf16* qp = MQ + (rowbase + 256 * c + 32 * wid + r32) * 512 + h * 128 + 8 * hi;
#pragma unroll
        for (int d0 = 0; d0 < 8; ++d0) qr[d0] = *(const bf16x8*)(qp + 16 * d0);
        U = U2[s * 2048 + 256 * c + 32 * wid + r32];
    }
    const int srow = tid >> 3, sp = tid & 7;
    const bf16* kg = MK + (rowbase + srow) * 512 + h * 128 + sp * 16;
    const bf16* vg = MV + (rowbase + srow) * 512 + h * 128 + sp * 16;
    const int kdst = (2 * sp) * 1024 + srow * 16;
    const int vdst = VOFF + (sp >> 1) * 4096 + srow * 64 + (sp & 1) * 32;
    v4u kpre0 = *(const v4u*)kg, kpre1 = *(const v4u*)(kg + 8), vpre0 = *(const v4u*)vg, vpre1 = *(const v4u*)(vg + 8);
    *(LAS v4u*)(lds + kdst) = kpre0; *(LAS v4u*)(lds + kdst + 1024) = kpre1; *(LAS v4u*)(lds + vdst) = vpre0; *(LAS v4u*)(lds + vdst + 16) = vpre1;
    __syncthreads();
    f32x16v o[4];
#pragma unroll
    for (int i = 0; i < 4; ++i)
#pragma unroll
        for (int r = 0; r < 16; ++r) o[i][r] = 0.f;
    float den = 0.f;
    const int qrel = 32 * wid + r32;
    const int kb = hi * 1024 + r32 * 16;
    const int vb = VOFF + ((lane >> 4) & 1) * 32 + (lane & 3) * 8 + (4 * hi + ((lane & 15) >> 2)) * 64;
    for (int kt = 0; kt < NT; ++kt) {
        const int cur = (kt & 1) * BUFB; const bool more = kt + 1 < NT;
        if (more) { const long off = (long)(kt + 1) * 64 * 512; kpre0 = *(const v4u*)(kg + off); kpre1 = *(const v4u*)(kg + off + 8); vpre0 = *(const v4u*)(vg + off); vpre1 = *(const v4u*)(vg + off + 8); }
        int jb = -1; bool active = true;
        if (!STATE) { jb = kt - 4 * c; active = (jb < 0) || (64 * jb <= 32 * wid + 31); }
        if (active) {
            f32x16v p0, p1;
#pragma unroll
            for (int r = 0; r < 16; ++r) { p0[r] = 0.f; p1[r] = 0.f; }
#pragma unroll
            for (int d0 = 0; d0 < 8; ++d0) { const bf16x8 a0 = *(const LAS bf16x8*)(lds + cur + kb + d0 * 2048), a1 = *(const LAS bf16x8*)(lds + cur + kb + d0 * 2048 + 512);
                p0 = __builtin_amdgcn_mfma_f32_32x32x16_bf16(a0, qr[d0], p0, 0, 0, 0); p1 = __builtin_amdgcn_mfma_f32_32x32x16_bf16(a1, qr[d0], p1, 0, 0, 0); }
            float dsum = 0.f;
#pragma unroll
            for (int g = 0; g < 4; ++g) { const f32x4v ga = *(const LAS f32x4v*)(g2l + 64 * kt + 8 * g + 4 * hi), gb = *(const LAS f32x4v*)(g2l + 64 * kt + 32 + 8 * g + 4 * hi);
#pragma unroll
                for (int e = 0; e < 4; ++e) { float w0 = __builtin_amdgcn_exp2f(ga[e] - U), w1 = __builtin_amdgcn_exp2f(gb[e] - U);
                    if (!STATE) { const int kv = 64 * jb + 8 * g + 4 * hi + e; if (jb >= 0) { w0 = (kv > qrel) ? 0.f : w0; w1 = (kv + 32 > qrel) ? 0.f : w1; } }
                    p0[4 * g + e] *= w0; p1[4 * g + e] *= w1; dsum += p0[4 * g + e] + p1[4 * g + e]; } }
            den += dsum;
            v4u pw[4];
            pw[0] = (v4u){cvtpk(p0[0], p0[1]), cvtpk(p0[2], p0[3]), cvtpk(p0[4], p0[5]), cvtpk(p0[6], p0[7])};
            pw[1] = (v4u){cvtpk(p0[8], p0[9]), cvtpk(p0[10], p0[11]), cvtpk(p0[12], p0[13]), cvtpk(p0[14], p0[15])};
            pw[2] = (v4u){cvtpk(p1[0], p1[1]), cvtpk(p1[2], p1[3]), cvtpk(p1[4], p1[5]), cvtpk(p1[6], p1[7])};
            pw[3] = (v4u){cvtpk(p1[8], p1[9]), cvtpk(p1[10], p1[11]), cvtpk(p1[12], p1[13]), cvtpk(p1[14], p1[15])};
#pragma unroll
            for (int db = 0; db < 4; ++db)
#pragma unroll
                for (int ks = 0; ks < 4; ++ks) { const s16x4v lo = vtr(lds + cur + vb + db * 4096 + ks * 1024), hh = vtr(lds + cur + vb + db * 4096 + ks * 1024 + 512);
                    const bf16x8 fr = (bf16x8){lo[0], lo[1], lo[2], lo[3], hh[0], hh[1], hh[2], hh[3]};
                    o[db] = __builtin_amdgcn_mfma_f32_32x32x16_bf16(__builtin_bit_cast(bf16x8, pw[ks]), fr, o[db], 0, 0, 0); }
        }
        if (more) { const int nb = cur ^ BUFB; *(LAS v4u*)(lds + nb + kdst) = kpre0; *(LAS v4u*)(lds + nb + kdst + 1024) = kpre1; *(LAS v4u*)(lds + nb + vdst) = vpre0; *(LAS v4u*)(lds + nb + vdst + 16) = vpre1; }
        __syncthreads();
    }
    den += __shfl_xor(den, 32);
    if (STATE) {
        if (wid < 4) {
            if (hi == 0) nout[s * 128 + 32 * wid + r32] = den;
#pragma unroll
            for (int db = 0; db < 4; ++db)
#pragma unroll
                for (int r = 0; r < 16; ++r) Cout[((long)s * 128 + 32 * db + r32) * 128 + 32 * wid + crow16(r, hi)] = o[db][r];
        }
        if (tid == 0) mout[s] = Mm[s * 2048 + 2047];
        __syncthreads();
        return;
    }
    LAS float* dsc = (LAS float*)(lds + DEN_OFF);
    if (hi == 0) dsc[wid * 32 + r32] = den;
    LAS float* stg = (LAS float*)(lds + wid * STG_W);
#pragma unroll
    for (int db = 0; db < 4; ++db)
#pragma unroll
        for (int r = 0; r < 16; ++r) stg[crow16(r, hi) * 132 + 32 * db + r32] = o[db][r];
    asm volatile("s_waitcnt lgkmcnt(0)" ::: "memory");
    {
        const int row = lane >> 1, half = lane & 1; const int t = 256 * c + 32 * wid + row; const long grow = rowbase + t;
        const float dn = dsc[wid * 32 + row], mt = Mm[s * 2048 + t];
        const float sc = 1.0f / fmaxf(fabsf(dn), __expf(-mt));
        float x[64]; float sum = 0.f;
#pragma unroll
        for (int i = 0; i < 16; ++i) { const f32x4v v = *(const LAS f32x4v*)(stg + row * 132 + 64 * half + 4 * i);
#pragma unroll
            for (int e = 0; e < 4; ++e) { x[4 * i + e] = v[e] * sc; sum += x[4 * i + e]; } }
        sum += __shfl_xor(sum, 1); const float mean = sum * (1.0f / 128.0f); float q = 0.f;
#pragma unroll
        for (int i = 0; i < 64; ++i) { x[i] -= mean; q += x[i] * x[i]; }
        q += __shfl_xor(q, 1); const float rstd = 1.0f / sqrtf(q * (1.0f / 128.0f) + LN_EPS);
        const float* gp = gnorm + h * 128 + 64 * half; const bf16* mop = MO + grow * 512 + h * 128 + 64 * half; bf16* outp = MIX + grow * 1024 + 512 + h * 128 + 64 * half;
#pragma unroll
        for (int i = 0; i < 8; ++i) { const v4u mo8 = *(const v4u*)(mop + 8 * i); const f32x4v g0 = *(const f32x4v*)(gp + 8 * i), g1 = *(const f32x4v*)(gp + 8 * i + 4); float y[8];
#pragma unroll
            for (int e = 0; e < 8; ++e) { const unsigned w = (e < 2) ? mo8.x : (e < 4) ? mo8.y : (e < 6) ? mo8.z : mo8.w; const float mo = bf2f((unsigned short)((e & 1) ? (w >> 16) : (w & 0xffffu)));
                const float gg = (e < 4) ? g0[e & 3] : g1[e & 3]; y[e] = x[8 * i + e] * rstd * gg * (1.0f / (1.0f + __expf(-mo))); }
            *(v4u*)(outp + 8 * i) = (v4u){cvtpk(y[0], y[1]), cvtpk(y[2], y[3]), cvtpk(y[4], y[5]), cvtpk(y[6], y[7])}; }
    }
    __syncthreads();
}
}

__device__ __forceinline__ f32x4v ntld4(const float* p) { return __builtin_nontemporal_load((const f32x4v*)p); }
__device__ __forceinline__ void decode_unit(int b, int hg, const bf16* __restrict__ Qb, const bf16* __restrict__ Kb, const bf16* __restrict__ Vb, const float* __restrict__ ck, const float* __restrict__ cv,
                                            const int* __restrict__ pt, bf16* MIX, LAS unsigned char* lds) {
    int tid_ = threadIdx.x; asm volatile("" : "+v"(tid_)); const int tid = tid_, lane = tid & 63; const int wid = __builtin_amdgcn_readfirstlane(tid >> 6);
    LAS float* S = (LAS float*)lds; LAS float* BS = S + 8192; LAS float* WMAX = BS + 32; LAS float* PSUM = WMAX + 8; LAS float* SOWN = PSUM + 8; LAS float* HMAX = SOWN + 4; LAS float* OPART = HMAX + 8;
    const long row = ROWS_P + b;
    const int hh = lane >> 4, dq = 4 * (lane & 15);
    float q0, q1, q2, q3;
    { const unsigned long long qq = *(const unsigned long long*)(Qb + row * 512 + (4 * hg + hh) * 64 + dq);
      q0 = bf2f((unsigned short)(qq & 0xffff)); q1 = bf2f((unsigned short)((qq >> 16) & 0xffff)); q2 = bf2f((unsigned short)((qq >> 32) & 0xffff)); q3 = bf2f((unsigned short)(qq >> 48)); }
    float bsum = 0.f;
    for (int pg = 0; pg < 2; ++pg) {
        const int page = pt[b * 16 + 2 * wid + pg];
        const float* kp = ck + (size_t)page * 65536 + hg * 256 + lane * 4;
        for (int i0 = 0; i0 < 128; i0 += 8) {
            f32x4v kk[8];
#pragma unroll
            for (int u = 0; u < 8; ++u) kk[u] = ntld4(kp + (size_t)(i0 + u) * 512);
#pragma unroll
            for (int u = 0; u < 8; ++u) { float d = kk[u][0] * q0 + kk[u][1] * q1 + kk[u][2] * q2 + kk[u][3] * q3;
                d += __shfl_xor(d, 1); d += __shfl_xor(d, 2); d += __shfl_xor(d, 4); d += __shfl_xor(d, 8);
                if ((lane & 15) == 0) S[hh * 2048 + wid * 256 + pg * 128 + i0 + u] = d;
                bsum += d; }
        }
    }
    if ((lane & 15) == 0) BS[hh * 8 + wid] = bsum;
    __syncthreads();
    const int h2 = wid >> 1, half = wid & 1;
    int s0 = 0, s1 = 0, s2 = 0;
    { float bs[8];
#pragma unroll
      for (int n = 0; n < 8; ++n) bs[n] = BS[h2 * 8 + n];
      int cnt = 0;
#pragma unroll
      for (int n = 0; n < 8; ++n) { int rank = 0;
#pragma unroll
          for (int n2 = 0; n2 < 8; ++n2) if (n2 != n) { const bool gt = (n2 < n) ? (bs[n2] >= bs[n]) : (bs[n2] > bs[n]); rank += gt ? 1 : 0; }
          if (rank < 3) { if (cnt == 0) s0 = n; else if (cnt == 1) s1 = n; else s2 = n; ++cnt; } } }
    const float sown = wave_sum(bf2f(Qb[row * 512 + (4 * hg + h2) * 64 + lane]) * bf2f(Kb[row * 512 + (4 * hg + h2) * 64 + lane]));
    float mx = sown;
#pragma unroll
    for (int j = 0; j < 3; ++j) { const int blk = (j == 0) ? s0 : (j == 1) ? s1 : s2; const LAS float* sp = S + h2 * 2048 + blk * 256 + half * 128;
        mx = fmaxf(mx, fmaxf(sp[lane], sp[lane + 64])); }
    mx = wave_max(mx);
    if (lane == 0) WMAX[wid] = mx;
    __syncthreads();
    const float hmax = fmaxf(WMAX[2 * h2], WMAX[2 * h2 + 1]);
    f32x4v oacc = (f32x4v){0.f, 0.f, 0.f, 0.f}; float ps = 0.f;
    const int ks = lane >> 4;
    for (int j = 0; j < 3; ++j) { const int blk = (j == 0) ? s0 : (j == 1) ? s1 : s2; const int page = pt[b * 16 + 2 * blk + half];
        const float* vp = cv + (size_t)page * 65536 + (size_t)(4 * hg + h2) * 64 + ks * 512 + dq;
        const LAS float* sp = S + h2 * 2048 + blk * 256 + half * 128 + ks;
        for (int it0 = 0; it0 < 32; it0 += 8) {
            f32x4v vv[8];
#pragma unroll
            for (int u = 0; u < 8; ++u) vv[u] = ntld4(vp + (size_t)(it0 + u) * 2048);
#pragma unroll
            for (int u = 0; u < 8; ++u) { const float p = __builtin_amdgcn_exp2f(sp[4 * (it0 + u)] - hmax); oacc += vv[u] * p; ps += p; }
        }
    }
#pragma unroll
    for (int e = 0; e < 4; ++e) { float v = oacc[e]; v += __shfl_xor(v, 16); v += __shfl_xor(v, 32); oacc[e] = v; }
    ps += __shfl_xor(ps, 16); ps += __shfl_xor(ps, 32);
    if (lane < 16) *(LAS f32x4v*)(OPART + wid * 64 + dq) = oacc;
    if (lane == 0) { PSUM[wid] = ps; if (half == 0) { SOWN[h2] = sown; HMAX[h2] = hmax; } }
    __syncthreads();
    if (tid < 256) { const int h3 = tid >> 6, d = tid & 63; const float po = __builtin_amdgcn_exp2f(SOWN[h3] - HMAX[h3]); const float vn = bf2f(Vb[row * 512 + (4 * hg + h3) * 64 + d]);
        const float ov = OPART[(2 * h3) * 64 + d] + OPART[(2 * h3 + 1) * 64 + d] + po * vn, sm = PSUM[2 * h3] + PSUM[2 * h3 + 1] + po;
        MIX[row * 1024 + (4 * hg + h3) * 64 + d] = (bf16)f2bf(ov / sm); }
    __syncthreads();
}

__device__ __forceinline__ void mls_unit(int b, int h, const bf16* __restrict__ MQ, const bf16* __restrict__ MK, const bf16* __restrict__ MV, const bf16* __restrict__ MO, const float* __restrict__ iglf,
                                         const float* __restrict__ C0, const float* __restrict__ n0, const float* __restrict__ m0p, const float* __restrict__ gnorm,
                                         float* Cn, float* nn, float* mn, bf16* MIX, LAS unsigned char* lds) {
    int tid_ = threadIdx.x; asm volatile("" : "+v"(tid_)); const int tid = tid_, lane = tid & 63; const int wid = __builtin_amdgcn_readfirstlane(tid >> 6);
    LAS float* qf = (LAS float*)lds; LAS float* kf = qf + 128; LAS float* vf = kf + 128; LAS float* NUM = vf + 128;
    const long row = ROWS_P + b; const int s = b * 4 + h;
    if (tid < 128) { qf[tid] = bf2f(MQ[row * 512 + h * 128 + tid]); kf[tid] = bf2f(MK[row * 512 + h * 128 + tid]); vf[tid] = bf2f(MV[row * 512 + h * 128 + tid]); }
    __syncthreads();
    const float qk = wave_sum(qf[lane] * kf[lane] + qf[lane + 64] * kf[lane + 64]);
    const float nq = wave_sum(qf[lane] * n0[s * 128 + lane] + qf[lane + 64] * n0[s * 128 + lane + 64]);
    const float ig = iglf[row * 8 + h], lf = iglf[row * 8 + 4 + h], m0 = m0p[s];
    const float mt = fmaxf(lf + m0, ig), w = __expf(lf + m0 - mt), gi = __expf(ig - mt), a = gi * qk;
    const float den = w * nq + a, dinv = 1.0f / fmaxf(fabsf(den), __expf(-mt));
    const int d4 = 4 * (lane & 31);
    const f32x4v q4 = *(const LAS f32x4v*)(qf + d4), k4 = *(const LAS f32x4v*)(kf + d4);
#pragma unroll
    for (int it = 0; it < 8; ++it) { const int v = 16 * wid + 2 * it + (lane >> 5); const size_t off = ((size_t)s * 128 + v) * 128 + d4;
        const f32x4v c0 = ntld4(C0 + off); const float vv = vf[v];
        float dot = c0[0] * q4[0] + c0[1] * q4[1] + c0[2] * q4[2] + c0[3] * q4[3];
        dot += __shfl_xor(dot, 1); dot += __shfl_xor(dot, 2); dot += __shfl_xor(dot, 4); dot += __shfl_xor(dot, 8); dot += __shfl_xor(dot, 16);
        const f32x4v cn = c0 * w + k4 * (gi * vv);
        __builtin_nontemporal_store(cn, (f32x4v*)(Cn + off));
        if ((lane & 31) == 0) NUM[v] = (w * dot + a * vv) * dinv; }
    if (tid < 128) nn[s * 128 + tid] = w * n0[s * 128 + tid] + gi * kf[tid];
    if (tid == 0) mn[s] = mt;
    __syncthreads();
    if (wid == 0) { const float x0 = NUM[lane], x1 = NUM[lane + 64]; const float mean = wave_sum(x0 + x1) * (1.0f / 128.0f); const float e0 = x0 - mean, e1 = x1 - mean;
        const float rstd = 1.0f / sqrtf(wave_sum(e0 * e0 + e1 * e1) * (1.0f / 128.0f) + LN_EPS);
        const float mo0 = bf2f(MO[row * 512 + h * 128 + lane]), mo1 = bf2f(MO[row * 512 + h * 128 + lane + 64]);
        MIX[row * 1024 + 512 + h * 128 + lane] = (bf16)f2bf(e0 * rstd * gnorm[h * 128 + lane] * (1.0f / (1.0f + __expf(-mo0))));
        MIX[row * 1024 + 512 + h * 128 + lane + 64] = (bf16)f2bf(e1 * rstd * gnorm[h * 128 + lane + 64] * (1.0f / (1.0f + __expf(-mo1)))); }
    __syncthreads();
}

constexpr int NWAVES = 8;
#ifndef MK_N_LAUNCHES
#define MK_N_LAUNCHES 1
#endif
constexpr int N_LAUNCHES = MK_N_LAUNCHES;
constexpr int N_PHASES = 9;
#ifndef EN_DEC
#define EN_DEC 1
#endif
#ifndef EN_MLS
#define EN_MLS 1
#endif
#ifndef EN_MOBA
#define EN_MOBA 1
#endif
#ifndef EN_ML
#define EN_ML 1
#endif
#ifndef EN_ST
#define EN_ST 1
#endif
#ifndef EN_GEMM
#define EN_GEMM 1
#endif
constexpr size_t MiB = 1u << 20;
constexpr size_t WS_CTL = 0, CTL_ZERO_BYTES = 1 * MiB;
constexpr size_t WS_KMEAN = 512 * 1024;
constexpr size_t WS_MOD = 2 * MiB;
constexpr size_t WS_WIN = 8 * MiB, WS_WOUT = 16 * MiB, WS_WGU = 18 * MiB, WS_WDN = 30 * MiB;
constexpr size_t WS_IGLF = 36 * MiB;
constexpr size_t WS_G2 = 37 * MiB, WS_U2 = WS_G2 + 256 * 1024, WS_MM = WS_U2 + 256 * 1024;
constexpr size_t WS_XN = 40 * MiB;
constexpr size_t WS_Q = 80 * MiB, WS_TSTRIDE = 20 * MiB;
constexpr size_t WS_MIX = 220 * MiB;
constexpr size_t WS_PRE = 256 * MiB, WS_X1 = 324 * MiB;
constexpr size_t WS_ACT = 392 * MiB;
constexpr size_t WS_END = 484 * MiB;
static_assert(WS_Q + 7 * WS_TSTRIDE <= WS_MIX && WS_MIX + (size_t)M_PAD * 1024 * 2 <= WS_PRE && WS_PRE + (size_t)M_PAD * 4096 <= WS_X1 && WS_X1 + (size_t)M_PAD * 4096 <= WS_ACT && WS_ACT + (size_t)M_PAD * DFF * 2 <= WS_END, "ws map");
static_assert((size_t)M_PAD * 512 * 2 <= WS_TSTRIDE && WS_XN + (size_t)M_PAD * 2048 <= WS_Q && WS_WDN + (size_t)1024 * DFF * 2 <= WS_IGLF && WS_WGU + (size_t)NGU * 2048 <= WS_WDN, "ws map 2");
constexpr int CW_TMO = 0, CW_Q = 64, CW_BAR = 4096;
constexpr size_t O_YP = 0, O_YS = 16777216, O_KP = 16908288, O_VP = 25296896, O_CP = 33685504, O_NP = 34209792, O_MP = 34213888, O_KS = 34213920, O_VS = 34279456, O_CS = 34344992, O_NS = 42733600, O_MS = 42799136, O_END = 42799648;
constexpr int RING_OFF = 0, RING_BYTES = 147456, LDSCTL_OFF = RING_BYTES, MISC_OFF = LDSCTL_OFF + 320, LDS_BYTES = RING_BYTES + 1024;
static_assert(ml::ML_LDS <= RING_BYTES && attn_body::ATTN_LDS_BYTES <= RING_BYTES && pg8::STAGE_BYTES <= RING_BYTES, "LDS map");

constexpr int N_CMP = 800, N_DEC = 256, N_MLS = 512, N_ITEMS = N_CMP + N_DEC + N_MLS;
enum { T_STATE = 0, T_ML = 1, T_MOBA = 2 };

__device__ __forceinline__ void transpose_item(const float* __restrict__ W, int ld, int nblk, bf16* WT, int K, int kind, LAS float* scr, int item, int lane) {
    const int kb = item / nblk, nb = item % nblk, k0 = 64 * kb, n0 = 32 * nb;
    const int drow = (kind == 0) ? n0 : (256 * (n0 >> 7) + (n0 & 127) + (kind == 2 ? 128 : 0));
#pragma unroll 8
    for (int i = 0; i < 32; ++i) { const int kk = 2 * i + (lane >> 5); scr[kk * 33 + (lane & 31)] = W[(size_t)(k0 + kk) * ld + n0 + (lane & 31)]; }
    LDS_WAIT(); asm volatile("" ::: "memory");
    const int c = lane & 7;
#pragma unroll
    for (int j = 0; j < 4; ++j) { const int n = (lane >> 3) + 8 * j; const LAS float* s = scr + (8 * c) * 33 + n;
        v4u o; o.x = pk2(s[0 * 33], s[1 * 33]); o.y = pk2(s[2 * 33], s[3 * 33]); o.z = pk2(s[4 * 33], s[5 * 33]); o.w = pk2(s[6 * 33], s[7 * 33]);
        *(GAS v4u*)(WT + (size_t)(drow + n) * K + k0 + 8 * c) = o; }
    LDS_WAIT(); asm volatile("" ::: "memory");
}
__device__ __forceinline__ float silu_f(float x) { return x / (1.0f + __expf(-x)); }

struct Args { const void* in[23]; float* out; unsigned char* ws; int ph_lo, ph_hi, li, pad; };
__global__ void __launch_bounds__(NWAVES * 64, 2) mega_fwd(Args args) {
    extern __shared__ __attribute__((aligned(16))) unsigned char lds_raw[];
    LAS unsigned char* lds = (LAS unsigned char*)lds_raw;
    volatile LAS unsigned* MISC = (volatile LAS unsigned*)(lds + MISC_OFF);
    const int tid = threadIdx.x, lane = tid & 63; const int wave = __builtin_amdgcn_readfirstlane(tid >> 6);
    const int G = gridDim.x; const int bx = blockIdx.x; const int vcu = (G % 8 == 0) ? (bx % 8) * (G / 8) + bx / 8 : bx;
    unsigned char* ws = args.ws;
    gu32* ctl = (gu32*)(ws + WS_CTL);
    const float* x_prompt = (const float*)args.in[0]; const float* x_sample = (const float*)args.in[1]; const float* cache_k = (const float*)args.in[2]; const float* cache_v = (const float*)args.in[3];
    const float* state_C = (const float*)args.in[4]; const float* state_n = (const float*)args.in[5]; const float* state_m = (const float*)args.in[6]; const int* page_table = (const int*)args.in[7];
    const float* c_prompt = (const float*)args.in[8]; const float* c_sample = (const float*)args.in[9]; const float* w_ada = (const float*)args.in[10]; const float* b_ada = (const float*)args.in[11];
    const float* w_in = (const float*)args.in[12]; const float* b_if = (const float*)args.in[13]; const float* gnorm = (const float*)args.in[14]; const float* w_out = (const float*)args.in[15];
    const float* ln1_g = (const float*)args.in[16]; const float* ln1_b = (const float*)args.in[17]; const float* w_gate = (const float*)args.in[18]; const float* w_up = (const float*)args.in[19];
    const float* w_down = (const float*)args.in[20]; const float* ln2_g = (const float*)args.in[21]; const float* ln2_b = (const float*)args.in[22];
    float* out = args.out;
    float* MOD = (float*)(ws + WS_MOD); float* KMEAN = (float*)(ws + WS_KMEAN); float* IGLF = (float*)(ws + WS_IGLF);
    float* G2 = (float*)(ws + WS_G2); float* U2 = (float*)(ws + WS_U2); float* MM = (float*)(ws + WS_MM);
    bf16* WIN_T = (bf16*)(ws + WS_WIN); bf16* WOUT_T = (bf16*)(ws + WS_WOUT); bf16* WGU_T = (bf16*)(ws + WS_WGU); bf16* WDN_T = (bf16*)(ws + WS_WDN);
    bf16* XN = (bf16*)(ws + WS_XN); bf16* QB = (bf16*)(ws + WS_Q); bf16* KB = (bf16*)(ws + WS_Q + WS_TSTRIDE); bf16* VB = (bf16*)(ws + WS_Q + 2 * WS_TSTRIDE);
    bf16* MQB = (bf16*)(ws + WS_Q + 3 * WS_TSTRIDE); bf16* MKB = (bf16*)(ws + WS_Q + 4 * WS_TSTRIDE); bf16* MVB = (bf16*)(ws + WS_Q + 5 * WS_TSTRIDE); bf16* MOB = (bf16*)(ws + WS_Q + 6 * WS_TSTRIDE);
    bf16* MIX = (bf16*)(ws + WS_MIX); float* PRE = (float*)(ws + WS_PRE); float* X1 = (float*)(ws + WS_X1); bf16* ACT = (bf16*)(ws + WS_ACT);

    for (int u = tid; u < (LDS_BYTES - LDSCTL_OFF) / 4; u += NWAVES * 64) ((LAS unsigned*)(lds + LDSCTL_OFF))[u] = 0u;
    __syncthreads();
    XcdBarrier bar; bar.bar = (unsigned*)(ctl + CW_BAR); bar.x = 0; bar.st = nullptr;
    if (N_LAUNCHES == 1) bar = xcd_barrier_post((unsigned*)(ctl + CW_BAR), MISC + 8);
#define GRID_BAR() do { if (N_LAUNCHES == 1) { xcd_barrier(bar); } } while (0)
    const int lo = args.ph_lo, hi = args.ph_hi;
#define IN(k) (lo <= (k) && (k) < hi)
#define BOTH(k) (IN(k) && IN((k) + 1))
    const int gw = vcu * NWAVES + wave, NGW = G * NWAVES;

    if (IN(0)) {
        LAS float* red = (LAS float*)(lds + RING_OFF);
        const int r32 = lane & 31, hi2 = lane >> 5;
        for (int cg = bx; cg < NMOD / 32; cg += G) {
            const int n0 = 32 * cg, kbase = 128 * wave;
            f32x16v acc[5];
#pragma unroll
            for (int rt = 0; rt < 5; ++rt)
#pragma unroll
                for (int r = 0; r < 16; ++r) acc[rt][r] = 0.f;
            for (int ks = 0; ks < 8; ++ks) { const int k0 = kbase + 16 * ks + 8 * hi2;
                float wv[8];
#pragma unroll
                for (int e = 0; e < 8; ++e) wv[e] = w_ada[(size_t)(k0 + e) * NMOD + n0 + r32];
                const v4u bw = (v4u){cvtpk(wv[0], wv[1]), cvtpk(wv[2], wv[3]), cvtpk(wv[4], wv[5]), cvtpk(wv[6], wv[7])};
#pragma unroll
                for (int rt = 0; rt < 5; ++rt) { const int row = 32 * rt + r32; v4u aw = (v4u){0u, 0u, 0u, 0u};
                    if (row < NBI) { const float* cp = (row < 8) ? c_prompt + (size_t)row * D : c_sample + (size_t)(row - 8) * D; const f32x4v a0 = *(const f32x4v*)(cp + k0), a1 = *(const f32x4v*)(cp + k0 + 4);
                        aw = (v4u){cvtpk(silu_f(a0[0]), silu_f(a0[1])), cvtpk(silu_f(a0[2]), silu_f(a0[3])), cvtpk(silu_f(a1[0]), silu_f(a1[1])), cvtpk(silu_f(a1[2]), silu_f(a1[3]))}; }
                    acc[rt] = __builtin_amdgcn_mfma_f32_32x32x16_bf16(__builtin_bit_cast(bf16x8, aw), __builtin_bit_cast(bf16x8, bw), acc[rt], 0, 0, 0); } }
            for (int w = 0; w < NWAVES; ++w) {
                if (wave == w) {
#pragma unroll
                    for (int rt = 0; rt < 5; ++rt)
#pragma unroll
                        for (int r = 0; r < 16; ++r) { const int idx = (32 * rt + crow16(r, hi2)) * 32 + r32; red[idx] = (w == 0) ? acc[rt][r] : red[idx] + acc[rt][r]; } }
                __syncthreads(); }
            for (int i = tid; i < NBI * 32; i += NWAVES * 64) { const int r = i >> 5, cc = i & 31; MOD[(size_t)r * NMOD + n0 + cc] = red[i] + b_ada[n0 + cc]; }
            __syncthreads();
        }
        LAS float* scr = (LAS float*)(lds + RING_OFF + wave * 16384);
        constexpr int I_IN = 16 * 112, I_OUT = 16 * 32, I_G = 16 * 88, I_D = 44 * 32, NIT = I_IN + I_OUT + 2 * I_G + I_D;
        for (int it = gw; it < NIT; it += NGW) { int r = it;
            if (r < I_IN) { transpose_item(w_in, IN_COLS, 112, WIN_T, 1024, 0, scr, r, lane); continue; } r -= I_IN;
            if (r < I_OUT) { transpose_item(w_out, 1024, 32, WOUT_T, 1024, 0, scr, r, lane); continue; } r -= I_OUT;
            if (r < I_G) { transpose_item(w_gate, DFF, 88, WGU_T, 1024, 1, scr, r, lane); continue; } r -= I_G;
            if (r < I_G) { transpose_item(w_up, DFF, 88, WGU_T, 1024, 2, scr, r, lane); continue; } r -= I_G;
            transpose_item(w_down, 1024, 32, WDN_T, DFF, 0, scr, r, lane); }
        if (BOTH(0)) GRID_BAR();
    }

    if (IN(1)) {
        LAS float* wg = (LAS float*)(lds + RING_OFF);
        for (int i = tid; i < 8192; i += NWAVES * 64) { const int e = i >> 10, k = i & 1023; wg[i] = w_in[(size_t)k * IN_COLS + NIN + e]; }
        __syncthreads();
        for (int m = gw; m < M_PAD; m += NGW) {
            if (m >= ROWS_REAL) { *(GAS v4u*)(XN + (size_t)m * D + 8 * lane) = (v4u){0u, 0u, 0u, 0u}; *(GAS v4u*)(XN + (size_t)m * D + 512 + 8 * lane) = (v4u){0u, 0u, 0u, 0u};
                *(GAS v4u*)(MIX + (size_t)m * D + 8 * lane) = (v4u){0u, 0u, 0u, 0u}; *(GAS v4u*)(MIX + (size_t)m * D + 512 + 8 * lane) = (v4u){0u, 0u, 0u, 0u}; continue; }
            const float* xr = (m < ROWS_P) ? x_prompt + (size_t)m * D : x_sample + (size_t)(m - ROWS_P) * D; const int bi = (m < ROWS_P) ? (m >> 11) : (8 + m - ROWS_P);
            const float* mr = MOD + (size_t)bi * NMOD;
            f32x4v hv[4]; float ga[8];
#pragma unroll
            for (int e = 0; e < 8; ++e) ga[e] = 0.f;
#pragma unroll
            for (int j = 0; j < 4; ++j) { const int k = 4 * (lane + 64 * j); const f32x4v xv = *(const f32x4v*)(xr + k), sh = *(const f32x4v*)(mr + k), sc = *(const f32x4v*)(mr + 1024 + k);
                hv[j] = xv * (sc + 1.0f) + sh;
                *(GAS unsigned long long*)(XN + (size_t)m * D + k) = (unsigned long long)pk2(hv[j][0], hv[j][1]) | ((unsigned long long)pk2(hv[j][2], hv[j][3]) << 32);
#pragma unroll
                for (int e = 0; e < 8; ++e) { const f32x4v w4 = *(const LAS f32x4v*)(wg + e * 1024 + k); ga[e] += hv[j][0] * w4[0] + hv[j][1] * w4[1] + hv[j][2] * w4[2] + hv[j][3] * w4[3]; } }
#pragma unroll
            for (int e = 0; e < 8; ++e) ga[e] = wave_sum(ga[e]);
            if (lane == 0) {
#pragma unroll
                for (int e = 0; e < 8; ++e) { const float z = ga[e] + b_if[e]; IGLF[(size_t)m * 8 + e] = (e < 4) ? z : (fminf(z, 0.f) - log1pf(__expf(-fabsf(z)))); } }
        }
        if (BOTH(1)) GRID_BAR();
    }

    if (IN(2)) {
        { pg8::Gemm g{XN, WIN_T, M_PAD, NIN, D}; pg8::StaticOrder S; S.init(M_PAD, NIN, G, bx);
          pg8::EpiIn E{QB, (size_t)(WS_TSTRIDE / 2), out, O_KP, O_KS, O_VP - O_KP, O_VS - O_KS, KMEAN, C2Q};
          if (EN_GEMM) pg8::gemm_phase<pg8::EpiIn, pg8::StaticOrder, true, true>(lds + RING_OFF, g, S, E); }
        if (bx >= G - 32 && wave == 0) { const int s = bx - (G - 32), b = s >> 2, h = s & 3;
            float fl[32], gl[32]; float f = 0.f;
#pragma unroll
            for (int i = 0; i < 32; ++i) { const size_t r = (size_t)b * SEQ + 32 * lane + i; const float lfv = IGLF[r * 8 + 4 + h]; gl[i] = IGLF[r * 8 + h]; f += lfv; fl[i] = f; }
            float incl = f;
#pragma unroll
            for (int o = 1; o < 64; o <<= 1) { const float t = __shfl_up(incl, o); if (lane >= o) incl += t; }
            const float excl = incl - f; float rm = -INFINITY;
#pragma unroll
            for (int i = 0; i < 32; ++i) { fl[i] += excl; gl[i] -= fl[i]; rm = fmaxf(rm, gl[i]); }
            float im = rm;
#pragma unroll
            for (int o = 1; o < 64; o <<= 1) { const float t = __shfl_up(im, o); if (lane >= o) im = fmaxf(im, t); }
            float em = __shfl_up(im, 1); if (lane == 0) em = -INFINITY;
            float run = fmaxf(em, 0.f);
#pragma unroll
            for (int i = 0; i < 32; ++i) { run = fmaxf(run, gl[i]); const size_t o = (size_t)s * SEQ + 32 * lane + i; G2[o] = gl[i] * LOG2E; U2[o] = run * LOG2E; MM[o] = fl[i] + run; }
        }
        if (BOTH(2)) GRID_BAR();
    }

    if (IN(3)) {
        LAS int* qslot = (LAS int*)(lds + LDSCTL_OFF + 64);
        for (;;) {
            if (tid == 0) *qslot = (int)__hip_atomic_fetch_add(ctl + CW_Q, 1u, RLX_AGENT);
            __syncthreads();
            const int x = __builtin_amdgcn_readfirstlane(*qslot);
            __syncthreads();
            if (x >= N_ITEMS) break;
            int typ = -1, id = 0;
            if (x < 768) { const int k = x / 3, r = x - 3 * k; if (r == 0) { typ = 3; id = k; } else { id = 2 * k + r - 1; } }
            else if (x < 1056) { id = 512 + (x - 768); }
            else { typ = 4; id = x - 1056; }
            if (typ == 3) { if (EN_DEC) decode_unit(id >> 1, id & 1, QB, KB, VB, cache_k, cache_v, page_table, MIX, lds + RING_OFF); }
            else if (typ == 4) { if (EN_MLS) mls_unit(id >> 2, id & 3, MQB, MKB, MVB, MOB, IGLF, state_C, state_n, state_m, gnorm, out + O_CS, out + O_NS, out + O_MS, MIX, lds + RING_OFF); }
            else {
                int ct, par, sub;
                if (id < 32) { ct = T_STATE; par = 0; sub = id; }
                else if (id < 160) { ct = T_ML; par = 7 - ((id - 32) >> 5); sub = (id - 32) & 31; }
                else if (id < 224) { ct = T_MOBA; par = 7; sub = id - 160; }
                else if (id < 256) { ct = T_ML; par = 3; sub = id - 224; }
                else if (id < 320) { ct = T_MOBA; par = 6; sub = id - 256; }
                else if (id < 352) { ct = T_ML; par = 2; sub = id - 320; }
                else if (id < 480) { ct = T_MOBA; par = 5 - ((id - 352) >> 6); sub = (id - 352) & 63; }
                else if (id < 512) { ct = T_ML; par = 1; sub = id - 480; }
                else if (id < 640) { ct = T_MOBA; par = 3 - ((id - 512) >> 6); sub = (id - 512) & 63; }
                else if (id < 672) { ct = T_ML; par = 0; sub = id - 640; }
                else { ct = T_MOBA; par = 1 - ((id - 672) >> 6); sub = (id - 672) & 63; }
                if (ct == T_MOBA) { if (EN_MOBA) attn_body::attn_unit<8>(sub >> 3, sub & 7, par, (const attn_body::bf16*)QB, (const attn_body::bf16*)KB, (const attn_body::bf16*)VB, (attn_body::bf16*)MIX, KMEAN, (char*)lds_raw + RING_OFF); }
                else if (ct == T_ML) { if (EN_ML) ml::mlstm_unit<false>(sub >> 2, sub & 3, par, MQB, MKB, MVB, MOB, G2, U2, MM, gnorm, MIX, nullptr, nullptr, nullptr, lds + RING_OFF); }
                else { if (EN_ST) ml::mlstm_unit<true>(sub >> 2, sub & 3, 0, MQB, MKB, MVB, MOB, G2, U2, MM, gnorm, MIX, out + O_CP, out + O_NP, out + O_MP, lds + RING_OFF); }
            }
        }
        if (BOTH(3)) GRID_BAR();
    }

    if (IN(4)) {
        pg8::Gemm g{MIX, WOUT_T, M_PAD, D, D}; pg8::StaticOrder S; S.init(M_PAD, D, G, bx);
        pg8::EpiRes E{x_prompt, x_sample, MOD, 2048, PRE, ALPHA};
        if (EN_GEMM) pg8::gemm_phase<pg8::EpiRes, pg8::StaticOrder, true, true>(lds + RING_OFF, g, S, E);
        if (BOTH(4)) GRID_BAR();
    }
    if (IN(5)) {
        for (int m = gw; m < ROWS_REAL; m += NGW) { const int bi = (m < ROWS_P) ? (m >> 11) : (8 + m - ROWS_P); const float* mr = MOD + (size_t)bi * NMOD; const float* pr = PRE + (size_t)m * D;
            f32x4v v[4]; float s = 0.f;
#pragma unroll
            for (int j = 0; j < 4; ++j) { v[j] = *(const f32x4v*)(pr + 4 * (lane + 64 * j)); s += (v[j][0] + v[j][1]) + (v[j][2] + v[j][3]); }
            const float mean = wave_sum(s) * (1.0f / D); float q = 0.f;
#pragma unroll
            for (int j = 0; j < 4; ++j) { v[j] = v[j] - mean; q += (v[j][0] * v[j][0] + v[j][1] * v[j][1]) + (v[j][2] * v[j][2] + v[j][3] * v[j][3]); }
            const float rstd = 1.0f / sqrtf(wave_sum(q) * (1.0f / D) + LN_EPS);
#pragma unroll
            for (int j = 0; j < 4; ++j) { const int k = 4 * (lane + 64 * j); const f32x4v g4 = *(const f32x4v*)(ln1_g + k), b4 = *(const f32x4v*)(ln1_b + k), sh = *(const f32x4v*)(mr + 3072 + k), sc = *(const f32x4v*)(mr + 4096 + k);
                const f32x4v x1 = v[j] * rstd * g4 + b4; *(f32x4v*)(X1 + (size_t)m * D + k) = x1; const f32x4v h2 = x1 * (sc + 1.0f) + sh;
                *(GAS unsigned long long*)(XN + (size_t)m * D + k) = (unsigned long long)pk2(h2[0], h2[1]) | ((unsigned long long)pk2(h2[2], h2[3]) << 32); } }
        if (BOTH(5)) GRID_BAR();
    }
    if (IN(6)) {
        pg8::Gemm g{XN, WGU_T, M_PAD, NGU, D}; pg8::StaticOrder S; S.init(M_PAD, NGU, G, bx);
        pg8::EpiSwiglu E{ACT, DFF};
        if (EN_GEMM) pg8::gemm_phase<pg8::EpiSwiglu, pg8::StaticOrder, true, true>(lds + RING_OFF, g, S, E);
        if (BOTH(6)) GRID_BAR();
    }
    if (IN(7)) {
        pg8::Gemm g{ACT, WDN_T, M_PAD, D, DFF}; pg8::StaticOrder S; S.init(M_PAD, D, G, bx);
        pg8::EpiRes E{X1, X1 + (size_t)ROWS_P * D, MOD, 5120, PRE, ALPHA};
        if (EN_GEMM) pg8::gemm_phase<pg8::EpiRes, pg8::StaticOrder, true, true>(lds + RING_OFF, g, S, E);
        if (BOTH(7)) GRID_BAR();
    }
    if (IN(8)) {
        for (int m = gw; m < ROWS_REAL; m += NGW) { const float* pr = PRE + (size_t)m * D; float* yo = (m < ROWS_P) ? out + O_YP + (size_t)m * D : out + O_YS + (size_t)(m - ROWS_P) * D;
            f32x4v v[4]; float s = 0.f;
#pragma unroll
            for (int j = 0; j < 4; ++j) { v[j] = *(const f32x4v*)(pr + 4 * (lane + 64 * j)); s += (v[j][0] + v[j][1]) + (v[j][2] + v[j][3]); }
            const float mean = wave_sum(s) * (1.0f / D); float q = 0.f;
#pragma unroll
            for (int j = 0; j < 4; ++j) { v[j] = v[j] - mean; q += (v[j][0] * v[j][0] + v[j][1] * v[j][1]) + (v[j][2] * v[j][2] + v[j][3] * v[j][3]); }
            const float rstd = 1.0f / sqrtf(wave_sum(q) * (1.0f / D) + LN_EPS);
#pragma unroll
            for (int j = 0; j < 4; ++j) { const int k = 4 * (lane + 64 * j); const f32x4v g4 = *(const f32x4v*)(ln2_g + k), b4 = *(const f32x4v*)(ln2_b + k); *(f32x4v*)(yo + k) = v[j] * rstd * g4 + b4; } }
    }
#undef IN
#undef BOTH
#undef GRID_BAR
}

extern "C" void kernel_launch(void* const* d_in, const int* in_sizes, int n_in, void* d_out, int out_size, void* d_ws, size_t ws_size, hipStream_t stream) {
    static int grid = 0;
    if (grid == 0) {
        if (n_in != 23 || out_size != (int)O_END || ws_size < WS_END) { fprintf(stderr, "kernel_launch: unexpected shapes: n_in %d out %d ws %zu; nothing launched\n", n_in, out_size, ws_size); grid = -1; return; }
        int dev = 0, cus = 0, per_cu = 0;
        if (hipGetDevice(&dev) != hipSuccess || hipDeviceGetAttribute(&cus, hipDeviceAttributeMultiprocessorCount, dev) != hipSuccess) { fprintf(stderr, "kernel_launch: device query failed\n"); grid = -1; return; }
        if (hipFuncSetAttribute((const void*)mega_fwd, hipFuncAttributeMaxDynamicSharedMemorySize, LDS_BYTES) != hipSuccess) { fprintf(stderr, "kernel_launch: hipFuncSetAttribute failed\n"); grid = -1; return; }
        if (hipOccupancyMaxActiveBlocksPerMultiprocessor(&per_cu, (const void*)mega_fwd, NWAVES * 64, LDS_BYTES) != hipSuccess || per_cu < 1)
            fprintf(stderr, "kernel_launch: note: occupancy query reports %d workgroups per CU\n", per_cu);
        (void)hipGetLastError();
        grid = cus;
    }
    if (grid < 0) return;
    if (hipMemsetAsync((char*)d_ws + WS_CTL, 0, CTL_ZERO_BYTES, stream) != hipSuccess) { fprintf(stderr, "kernel_launch: memset failed\n"); return; }
    Args a{};
    for (int i = 0; i < 23; ++i) a.in[i] = d_in[i];
    a.out = (float*)d_out; a.ws = (unsigned char*)d_ws;
    for (int li = 0; li < N_LAUNCHES; ++li) {
        a.ph_lo = (N_LAUNCHES == 1) ? 0 : li; a.ph_hi = (N_LAUNCHES == 1) ? N_PHASES : li + 1; a.li = li;
        hipLaunchKernelGGL(mega_fwd, dim3(grid), dim3(NWAVES * 64), LDS_BYTES, stream, a);
        const hipError_t le = hipPeekAtLastError();
        if (le != hipSuccess) { fprintf(stderr, "kernel_launch: launch %d failed: %s\n", li, hipGetErrorName(le)); break; }
    }
}
```
